# Optimizing an MI355X kernel written in HIP

```python
import math
import numpy as np
import jax
import jax.numpy as jnp
from jax import lax

D_MODEL = 2048
BATCH = 8
SEQ = 2048
DEPTH = 2

GRID_W = 64
CTX_LEN = 256

NA_HEADS = 16
NA_HEAD_DIM = 64
NA_W = NA_HEADS * NA_HEAD_DIM
NA_WIN_H = 8
NA_WIN_W = 16
NA_COL_BLOCK = 16
NA_COL_HALO = 32

RW_HEADS = 16
RW_HEAD = 64
RW_W = RW_HEADS * RW_HEAD
RW_DECAY_LORA = 64
RW_AAA_LORA = 64
RW_GATE_LORA = 160
RW_SHIFT_W = 3 * RW_W + 2 * RW_DECAY_LORA + 2 * RW_AAA_LORA + RW_GATE_LORA
GN_EPS = 64e-5

MLA_HEADS = 16
MLA_NOPE = 64
MLA_ROPE = 32
MLA_V = 64
MLA_QK = MLA_NOPE + MLA_ROPE
MLA_Q_LORA = 512
MLA_KV_LORA = 256
MLA_Q_BLOCK = 128
ROPE_THETA = 10000.0

N_BRANCH = 3
BRANCH_W = 1024
IN_SPLIT = (3 * NA_W, RW_SHIFT_W, MLA_Q_LORA, MLA_KV_LORA, MLA_ROPE, N_BRANCH * D_MODEL)
IN_W = 3 * NA_W + RW_SHIFT_W + MLA_Q_LORA + MLA_KV_LORA + MLA_ROPE + N_BRANCH * D_MODEL
RW_SPLIT = (RW_W, RW_W, RW_W, 2 * RW_DECAY_LORA, 2 * RW_AAA_LORA, RW_GATE_LORA)

N_EXPERTS = 16
N_GROUPS = 4
EXPERTS_PER_GROUP = N_EXPERTS // N_GROUPS
TOP_K = 2
D_EXPERT = 1024
MOE_BLOCK = 256

NORM_EPS = 1e-6
NEG_INF = -1e30

kernel_name = "hybrid_na_rwkv7_mla_grouped_moe_dit"


def _split(x, sizes):
    idx = np.cumsum(sizes)[:-1].tolist()
    return jnp.split(x, idx, axis=-1)


def rms_norm(x, g):
    xf = x.astype(jnp.float32)
    y = xf * lax.rsqrt(jnp.mean(xf * xf, axis=-1, keepdims=True) + NORM_EPS)
    return (y * g.astype(jnp.float32)).astype(x.dtype)


def axial_rope(x, pos):
    half = MLA_ROPE // 2
    nf = half // 2
    inv = ROPE_THETA ** (-jnp.arange(nf, dtype=jnp.float32) / nf)
    shape = (pos.shape[0],) + (1,) * (x.ndim - 3) + (nf,)
    xf = x.astype(jnp.float32)

    def rot(v, p):
        ang = (p.astype(jnp.float32)[:, None] * inv).reshape(shape)
        cs, sn = jnp.cos(ang), jnp.sin(ang)
        v1, v2 = v[..., :nf], v[..., nf:]
        return jnp.concatenate([v1 * cs - v2 * sn, v1 * sn + v2 * cs], axis=-1)

    out = jnp.concatenate([rot(xf[..., :half], pos // GRID_W), rot(xf[..., half:], pos % GRID_W)], axis=-1)
    return out.astype(x.dtype)


def full_attention(q, k, v, scale):
    s = jnp.einsum('bqhd,bkhd->bhqk', q, k).astype(jnp.float32) * scale
    p = jax.nn.softmax(s, axis=-1).astype(v.dtype)
    return jnp.einsum('bhqk,bkhd->bqhd', p, v)


def blocked_attention(q, k, v, scale):
    B, T, H, Dq = q.shape
    nb = T // MLA_Q_BLOCK
    qb = jnp.moveaxis(q.reshape(B, nb, MLA_Q_BLOCK, H, Dq), 1, 0)

    def one_block(qi):
        s = jnp.einsum('bqhd,bkhd->bhqk', qi, k).astype(jnp.float32) * scale
        p = jax.nn.softmax(s, axis=-1).astype(v.dtype)
        return jnp.einsum('bhqk,bkhd->bqhd', p, v)

    out = lax.map(one_block, qb)
    return jnp.moveaxis(out, 0, 1).reshape(B, T, H, v.shape[-1])


def neighbourhood_attention(q, k, v, k_ctx, v_ctx, rpb):
    B, T, H, Dh = q.shape
    rows = T // GRID_W
    kh = min(NA_WIN_H, rows)
    n_cb = GRID_W // NA_COL_BLOCK
    scale = 1.0 / math.sqrt(Dh)
    j = np.arange(GRID_W).reshape(n_cb, NA_COL_BLOCK)
    col_start = np.clip(j - NA_WIN_W // 2, 0, GRID_W - NA_WIN_W)
    halo_start = np.clip(np.arange(n_cb) * NA_COL_BLOCK - NA_WIN_W // 2, 0, GRID_W - NA_COL_HALO)
    halo_cols = halo_start[:, None] + np.arange(NA_COL_HALO)
    col_valid = ((halo_cols[:, None, :] >= col_start[:, :, None])
                 & (halo_cols[:, None, :] < col_start[:, :, None] + NA_WIN_W))
    col_off = np.clip(halo_cols[:, None, :] - j[:, :, None] + NA_WIN_W - 1, 0, 2 * NA_WIN_W - 2)
    rpb_cols = jnp.where(col_valid, rpb[:, :, col_off].astype(jnp.float32), NEG_INF)

    qg = q.reshape(B, rows, n_cb, NA_COL_BLOCK, H, Dh)
    k_halo = k.reshape(B, rows, GRID_W, H, Dh)[:, :, halo_cols]
    v_halo = v.reshape(B, rows, GRID_W, H, Dh)[:, :, halo_cols]
    n_loc = kh * NA_COL_HALO

    def one_row(i):
        r0 = jnp.clip(i - kh // 2, 0, rows - kh)
        kr = lax.dynamic_slice_in_dim(k_halo, r0, kh, axis=1)
        vr = lax.dynamic_slice_in_dim(v_halo, r0, kh, axis=1)
        qr = lax.dynamic_index_in_dim(qg, i, axis=1, keepdims=False)
        row_idx = r0 - i + jnp.arange(kh) + NA_WIN_H - 1
        bias = jnp.transpose(rpb_cols[:, row_idx], (0, 2, 3, 1, 4))
        s_loc = jnp.einsum('bnqhd,brnchd->bhnqrc', qr, kr).astype(jnp.float32) * scale + bias
        s_ctx = jnp.einsum('bnqhd,bchd->bhnqc', qr, k_ctx).astype(jnp.float32) * scale
        s = jnp.concatenate([s_loc.reshape(s_loc.shape[:4] + (n_loc,)), s_ctx], axis=-1)
        p = jax.nn.softmax(s, axis=-1).astype(v.dtype)
        p_loc = p[..., :n_loc].reshape(s_loc.shape)
        return (jnp.einsum('bhnqrc,brnchd->bnqhd', p_loc, vr)
                + jnp.einsum('bhnqc,bchd->bnqhd', p[..., n_loc:], v_ctx))

    out = lax.map(one_row, jnp.arange(rows))
    return jnp.moveaxis(out, 0, 1).reshape(B, T, H, Dh)


def centred_shift(u, mu):
    pad = jnp.pad(u, ((0, 0), (1, 1), (0, 0)))
    return u + mu * (0.5 * (pad[:, :-2] + pad[:, 2:]) - u)


def rwkv_prepare(u, mu, w0, w_up, a0, a_up, g_up, k_k, k_a):
    B, T, _ = u.shape
    u = centred_shift(u, mu)
    r, k, v, wd, ad, gd = _split(u, RW_SPLIT)
    wd = wd.reshape(B, T, 2, RW_DECAY_LORA)
    ad = ad.reshape(B, T, 2, RW_AAA_LORA)
    w = -jax.nn.softplus(-(w0 + jnp.einsum('btzl,zlc->btzc', jnp.tanh(wd), w_up)).astype(jnp.float32)) - 0.5
    decay = jnp.exp(-jnp.exp(w))
    a = jax.nn.sigmoid((a0 + jnp.einsum('btzl,zlc->btzc', ad, a_up)).astype(jnp.float32))
    g = jax.nn.sigmoid(gd) @ g_up
    heads = lambda t: t.reshape(t.shape[:-1] + (RW_HEADS, RW_HEAD))
    kk = heads(k * k_k).astype(jnp.float32)
    kk = kk / jnp.maximum(jnp.sqrt(jnp.sum(kk * kk, axis=-1, keepdims=True)), 1e-12)
    kd = k[:, :, None, :] * (1.0 + (a - 1.0) * k_a)
    return (heads(r), heads(decay), kk, heads(a), heads(kd), heads(v), g, heads(k))


def _rwkv_step(state, inp):
    r, w, kk, a, k, v = inp
    sk = jnp.einsum('zbhvk,zbhk->zbhv', state, kk)
    state = (state * w[..., None, :] - sk[..., :, None] * (kk * a)[..., None, :]
             + v[..., :, None] * k[..., None, :])
    return state, jnp.einsum('zbhvk,zbhk->zbhv', state, r)


def rwkv_bidir_scan(state0, prep):
    r, decay, kk, a, kd, v = prep[:6]
    both = lambda t: jnp.stack([t, t[:, ::-1]], axis=0)
    per_dir = lambda t: jnp.stack([t[:, :, 0], t[:, ::-1, 1]], axis=0)
    seq = (both(r), per_dir(decay), both(kk), per_dir(a), per_dir(kd), both(v))
    seq = tuple(jnp.moveaxis(t.astype(jnp.float32), 2, 0) for t in seq)
    state, ys = lax.scan(_rwkv_step, state0, seq)
    y = ys[:, 0] + ys[::-1, 1]
    return state, jnp.moveaxis(y, 0, 1)


def rwkv_output(y, prep, r_k, gn_w, gn_b, dtype):
    r, k, v, g = prep[0], prep[7], prep[5], prep[6]
    B, T = y.shape[:2]
    mean = jnp.mean(y, axis=-1, keepdims=True)
    var = jnp.mean(jnp.square(y - mean), axis=-1, keepdims=True)
    yn = ((y - mean) * lax.rsqrt(var + GN_EPS)).reshape(B, T, RW_W) * gn_w + gn_b
    bonus = (jnp.sum(r * k * r_k, axis=-1, keepdims=True) * v).reshape(B, T, RW_W)
    return ((yn + bonus) * g).astype(dtype)


def mla_q(cq, q_norm_g, w_uq, pos):
    B, T, _ = cq.shape
    q = (rms_norm(cq, q_norm_g) @ w_uq).reshape(B, T, MLA_HEADS, MLA_QK)
    if pos is None:
        return q
    return jnp.concatenate([q[..., :MLA_NOPE], axial_rope(q[..., MLA_NOPE:], pos)], axis=-1)


def mla_kv(ckv, k_rope, kv_norm_g, w_ukv, pos):
    B, T, _ = ckv.shape
    kv = (rms_norm(ckv, kv_norm_g) @ w_ukv).reshape(B, T, MLA_HEADS, MLA_NOPE + MLA_V)
    if pos is not None:
        k_rope = axial_rope(k_rope, pos)
    k = jnp.concatenate([kv[..., :MLA_NOPE],
                         jnp.broadcast_to(k_rope[:, :, None, :], (B, T, MLA_HEADS, MLA_ROPE))], axis=-1)
    return k, kv[..., MLA_NOPE:]


def branch_merge(ys, gates, w_branch, w_out):
    B, T, _ = gates.shape
    gate = jax.nn.sigmoid(gates.astype(jnp.float32)).astype(ys[0].dtype).reshape(B, T, N_BRANCH, D_MODEL)
    merged = gate[:, :, 0] * (ys[0] @ w_branch[0])
    for z in range(1, N_BRANCH):
        merged = merged + gate[:, :, z] * (ys[z] @ w_branch[z])
    return merged @ w_out


def hybrid_mixer(h, hc, pos, w_in, na_rpb, rw_shift_mu, rw_w0, rw_w_up, rw_a0, rw_a_up, rw_g_up,
                 rw_k_k, rw_k_a, rw_r_k, rw_gn_w, rw_gn_b, mla_q_norm_g, mla_w_uq, mla_kv_norm_g,
                 mla_w_ukv, w_branch, w_out, need_ctx):
    B, T, _ = h.shape
    Tc = hc.shape[1]
    na_u, rw_u, cq, ckv, kr, gates = _split(h @ w_in, IN_SPLIT)
    na_uc, rw_uc, cqc, ckvc, krc, gatesc = _split(hc @ w_in, IN_SPLIT)

    q, k, v = [t.reshape(B, T, NA_HEADS, NA_HEAD_DIM) for t in jnp.split(na_u, 3, axis=-1)]
    qc, kc, vc = [t.reshape(B, Tc, NA_HEADS, NA_HEAD_DIM) for t in jnp.split(na_uc, 3, axis=-1)]
    y_na = neighbourhood_attention(q, k, v, kc, vc, na_rpb).reshape(B, T, NA_W)

    rw_args = (rw_shift_mu, rw_w0, rw_w_up, rw_a0, rw_a_up, rw_g_up, rw_k_k, rw_k_a)
    prep = rwkv_prepare(rw_u, *rw_args)
    prep_c = rwkv_prepare(rw_uc, *rw_args)
    state0 = jnp.zeros((2, B, RW_HEADS, RW_HEAD, RW_HEAD), jnp.float32)
    state_ctx, yc_scan = rwkv_bidir_scan(state0, prep_c)
    _, y_scan = rwkv_bidir_scan(state_ctx, prep)
    y_rw = rwkv_output(y_scan, prep, rw_r_k, rw_gn_w, rw_gn_b, h.dtype)

    mla_scale = 1.0 / math.sqrt(MLA_QK)
    qm = mla_q(cq, mla_q_norm_g, mla_w_uq, pos)
    km, vm = mla_kv(ckv, kr, mla_kv_norm_g, mla_w_ukv, pos)
    kmc, vmc = mla_kv(ckvc, krc, mla_kv_norm_g, mla_w_ukv, None)
    y_mla = blocked_attention(qm, jnp.concatenate([km, kmc], axis=1), jnp.concatenate([vm, vmc], axis=1),
                              mla_scale).reshape(B, T, MLA_HEADS * MLA_V)

    out = branch_merge((y_na, y_rw, y_mla), gates, w_branch, w_out)
    if not need_ctx:
        return out, None
    yc_na = full_attention(qc, kc, vc, 1.0 / math.sqrt(NA_HEAD_DIM)).reshape(B, Tc, NA_W)
    yc_rw = rwkv_output(yc_scan, prep_c, rw_r_k, rw_gn_w, rw_gn_b, hc.dtype)
    qmc = mla_q(cqc, mla_q_norm_g, mla_w_uq, None)
    yc_mla = full_attention(qmc, kmc, vmc, mla_scale).reshape(B, Tc, MLA_HEADS * MLA_V)
    out_c = branch_merge((yc_na, yc_rw, yc_mla), gatesc, w_branch, w_out)
    return out, out_c


def moe_ffn(h, router_w, router_bias, w_gate_up, w_down):
    n = h.shape[0]
    scores = jax.nn.sigmoid((h @ router_w).astype(jnp.float32))
    sel = scores + router_bias.astype(jnp.float32)
    grp_score = jnp.sum(lax.top_k(sel.reshape(n, N_GROUPS, EXPERTS_PER_GROUP), TOP_K)[0], axis=-1)
    best_group = jnp.argmax(grp_score, axis=-1)
    in_group = (jnp.arange(N_EXPERTS) // EXPERTS_PER_GROUP)[None, :] == best_group[:, None]
    _, top_e = lax.top_k(jnp.where(in_group, sel, -jnp.inf), TOP_K)
    top_s = jnp.take_along_axis(scores, top_e, axis=-1)
    weights = top_s / jnp.sum(top_s, axis=-1, keepdims=True)

    m = n * TOP_K
    slot_e = top_e.reshape(-1)
    slot_tok = jnp.repeat(jnp.arange(n), TOP_K)
    order = jnp.argsort(slot_e, stable=True)
    e_s, tok_s, w_s = slot_e[order], slot_tok[order], weights.reshape(-1)[order]
    counts = jnp.bincount(slot_e, length=N_EXPERTS)
    padded = (counts + MOE_BLOCK - 1) // MOE_BLOCK * MOE_BLOCK
    starts = jnp.cumsum(counts) - counts
    pends = jnp.cumsum(padded)
    dest = (pends - padded)[e_s] + jnp.arange(m) - starts[e_s]
    n_blocks = m // MOE_BLOCK + N_EXPERTS
    buf = jnp.zeros((n_blocks * MOE_BLOCK, h.shape[1]), h.dtype).at[dest].set(h[tok_s])
    blk_e = jnp.clip(jnp.searchsorted(pends, jnp.arange(n_blocks) * MOE_BLOCK, side='right'), 0, N_EXPERTS - 1)

    def expert_block(args):
        xb, e = args
        gte, up = jnp.split(xb @ w_gate_up[e], 2, axis=-1)
        return (jax.nn.silu(gte) * up) @ w_down[e]

    out_buf = lax.map(expert_block, (buf.reshape(n_blocks, MOE_BLOCK, -1), blk_e)).reshape(buf.shape)
    contrib = out_buf[dest] * w_s[:, None].astype(h.dtype)
    return jnp.zeros_like(h).at[tok_s].add(contrib)


def setup_inputs(seed: int = 0) -> dict:
    key = jax.random.key(seed)
    ks = iter(jax.random.split(key, 40))
    L, D, F = DEPTH, D_MODEL, D_EXPERT
    nrm = lambda shape, s: jax.random.normal(next(ks), shape, jnp.float32) * s
    uni = lambda shape, lo, hi: jax.random.uniform(next(ks), shape, jnp.float32, lo, hi)
    return {
        "x": nrm((BATCH, SEQ, D), 1.0),
        "c": nrm((BATCH, D), 1.0),
        "ctx": nrm((BATCH, CTX_LEN, D), 1.0),
        "c_ctx": nrm((D,), 1.0),
        "w_mod": nrm((L, D, 6 * D), 0.5 * D ** -0.5),
        "b_mod": nrm((L, 6 * D), 0.01),
        "norm1_g": 1.0 + nrm((L, D), 0.01),
        "norm2_g": 1.0 + nrm((L, D), 0.01),
        "w_in": nrm((L, D, IN_W), D ** -0.5),
        "na_rpb": nrm((L, NA_HEADS, 2 * NA_WIN_H - 1, 2 * NA_WIN_W - 1), 0.1),
        "rw_shift_mu": uni((L, RW_SHIFT_W), 0.0, 1.0),
        "rw_w0": uni((L, 2, RW_W), -6.0, 0.0),
        "rw_w_up": nrm((L, 2, RW_DECAY_LORA, RW_W), 0.5 * RW_DECAY_LORA ** -0.5),
        "rw_a0": nrm((L, 2, RW_W), 0.5),
        "rw_a_up": nrm((L, 2, RW_AAA_LORA, RW_W), 0.5 * RW_AAA_LORA ** -0.5),
        "rw_g_up": nrm((L, RW_GATE_LORA, RW_W), RW_GATE_LORA ** -0.5),
        "rw_k_k": 0.85 + nrm((L, RW_W), 0.05),
        "rw_k_a": 1.0 + nrm((L, RW_W), 0.05),
        "rw_r_k": nrm((L, RW_HEADS, RW_HEAD), 0.1),
        "rw_gn_w": 1.0 + nrm((L, RW_W), 0.01),
        "rw_gn_b": nrm((L, RW_W), 0.01),
        "mla_q_norm_g": 1.0 + nrm((L, MLA_Q_LORA), 0.01),
        "mla_w_uq": nrm((L, MLA_Q_LORA, MLA_HEADS * MLA_QK), MLA_Q_LORA ** -0.5),
        "mla_kv_norm_g": 1.0 + nrm((L, MLA_KV_LORA), 0.01),
        "mla_w_ukv": nrm((L, MLA_KV_LORA, MLA_HEADS * (MLA_NOPE + MLA_V)), MLA_KV_LORA ** -0.5),
        "w_branch": nrm((L, N_BRANCH, BRANCH_W, D), BRANCH_W ** -0.5),
        "w_out": nrm((L, D, D), D ** -0.5),
        "router_w": nrm((D, N_EXPERTS), D ** -0.5),
        "router_bias": nrm((N_EXPERTS,), 0.01),
        "moe_w_gate_up": nrm((L, N_EXPERTS, D, 2 * F), D ** -0.5),
        "moe_w_down": nrm((L, N_EXPERTS, F, D), F ** -0.5),
        "final_norm_g": 1.0 + nrm((D,), 0.01),
    }


def reference(x, c, ctx, c_ctx, w_mod, b_mod, norm1_g, norm2_g, w_in, na_rpb, rw_shift_mu, rw_w0,
              rw_w_up, rw_a0, rw_a_up, rw_g_up, rw_k_k, rw_k_a, rw_r_k, rw_gn_w, rw_gn_b,
              mla_q_norm_g, mla_w_uq, mla_kv_norm_g, mla_w_ukv, w_branch, w_out, router_w,
              router_bias, moe_w_gate_up, moe_w_down, final_norm_g):
    B, T, D = x.shape
    Tc = ctx.shape[1]
    pos = jnp.arange(T, dtype=jnp.int32)
    xc = ctx
    for layer in range(DEPTH):
        need_ctx = layer < DEPTH - 1
        mod = jax.nn.silu(c) @ w_mod[layer] + b_mod[layer]
        mod_c = jax.nn.silu(c_ctx) @ w_mod[layer] + b_mod[layer]
        sh1, sc1, g1, sh2, sc2, g2 = [m[:, None, :] for m in jnp.split(mod, 6, axis=-1)]
        sh1c, sc1c, g1c, sh2c, sc2c, g2c = jnp.split(mod_c, 6, axis=-1)
        h = rms_norm(x, norm1_g[layer]) * (1.0 + sc1) + sh1
        hc = rms_norm(xc, norm1_g[layer]) * (1.0 + sc1c) + sh1c
        y, yc = hybrid_mixer(h, hc, pos, w_in[layer], na_rpb[layer], rw_shift_mu[layer], rw_w0[layer],
                             rw_w_up[layer], rw_a0[layer], rw_a_up[layer], rw_g_up[layer], rw_k_k[layer],
                             rw_k_a[layer], rw_r_k[layer], rw_gn_w[layer], rw_gn_b[layer],
                             mla_q_norm_g[layer], mla_w_uq[layer], mla_kv_norm_g[layer], mla_w_ukv[layer],
                             w_branch[layer], w_out[layer], need_ctx)
        x = x + g1 * y
        h2 = rms_norm(x, norm2_g[layer]) * (1.0 + sc2) + sh2
        if need_ctx:
            xc = xc + g1c * yc
            h2c = rms_norm(xc, norm2_g[layer]) * (1.0 + sc2c) + sh2c
            f = moe_ffn(jnp.concatenate([h2.reshape(-1, D), h2c.reshape(-1, D)], axis=0),
                        router_w, router_bias, moe_w_gate_up[layer], moe_w_down[layer])
            x = x + g2 * f[:B * T].reshape(B, T, D)
            xc = xc + g2c * f[B * T:].reshape(B, Tc, D)
        else:
            f = moe_ffn(h2.reshape(-1, D), router_w, router_bias, moe_w_gate_up[layer], moe_w_down[layer])
            x = x + g2 * f.reshape(B, T, D)
    return rms_norm(x, final_norm_g)
```

```cpp
#include <hip/hip_runtime.h>
#include <cstdio>
#include <cstdint>

#ifndef MK_N_LAUNCHES
#define MK_N_LAUNCHES 1
#endif

#ifndef REPMASK
#define REPMASK 0u
#endif
#define REPL(j) for (int rep_ = 0; rep_ < 1 + (int)(((REPMASK) >> (j)) & 1u); ++rep_, (REPMASK) ? __syncthreads() : (void)0)
#ifndef MIXM
#define MIXM 15
#endif
#ifndef SUBM
#define SUBM 15
#endif
#define PHEN(j) (((PM) >> (j)) & 1u)
#define LAS __attribute__((address_space(3)))
#define GAS __attribute__((address_space(1)))
typedef unsigned short bf16;
typedef short bf16x8 __attribute__((ext_vector_type(8)));
typedef float f32x4 __attribute__((ext_vector_type(4)));
typedef float f32x2 __attribute__((ext_vector_type(2)));
typedef unsigned u32x4 __attribute__((ext_vector_type(4)));
typedef unsigned u32x2 __attribute__((ext_vector_type(2)));

constexpr int D = 2048, NB = 8, T = 2048, TC = 256, ML = NB * T, MC = NB * TC, M = ML + MC;
constexpr int INW = 13504;
constexpr int UW = 12544;
constexpr int INWP = 13568;
constexpr int O_NAQ = 0, O_NAK = 1024, O_RW = 2048, O_CQ = 5536, O_CKV = 6048, O_KR = 6304, O_GATE = 6336;
constexpr int NE = 16, FE = 1024, MAXT = 160;
constexpr int NWAVES = 8, NTHR = 512;
constexpr int PH_PER_LAYER = 13, N_PHASES = 1 + 2 * PH_PER_LAYER;

constexpr size_t MiB = 1u << 20;
constexpr size_t WS_CTL = 0, CTL_ZERO_BYTES = 1 * MiB;
constexpr size_t WS_MODF = 1 * MiB;
constexpr size_t WS_ROUTE = 2 * MiB;
constexpr size_t WS_WIN = 4 * MiB, WS_WB = 57 * MiB, WS_WO = 69 * MiB, WS_GU = 77 * MiB, WS_DN = 205 * MiB, WS_WUQ = 269 * MiB, WS_WUKV = 271 * MiB, WS_WA = 272 * MiB, WS_WG = 274 * MiB;
constexpr size_t WS_XR = 276 * MiB, WS_H = 420 * MiB, WS_BIG = 492 * MiB;
constexpr size_t WS_BUF = WS_BIG, WS_ACT = WS_BIG + 160 * MiB, WS_OUTB = WS_BIG + 240 * MiB;
constexpr size_t WS_RS = 969 * MiB, WS_KS = 1005 * MiB, WS_VS = 1041 * MiB, WS_KK = 1077 * MiB;
constexpr size_t WS_DEC = 1113 * MiB, WS_AA = 1257 * MiB, WS_G = 1329 * MiB, WS_YS = 1365 * MiB;
constexpr size_t WS_MRG = WS_DEC, WS_MB = WS_AA;
constexpr size_t WS_Q = 1509 * MiB, WS_KV = 1563 * MiB, WS_YNA = 1635 * MiB, WS_YRW = 1671 * MiB, WS_YMLA = 1707 * MiB;
constexpr size_t WS_LA = 1743 * MiB, WS_LG = 1752 * MiB, WS_CQN = 1761 * MiB, WS_CKVN = 1779 * MiB, WS_VTM = 1790 * MiB, WS_VTN = 1826 * MiB, WS_WRB = 1862 * MiB, WS_CB = 1865 * MiB, WS_DN1 = 1866 * MiB, WS_END = 1930 * MiB;
static_assert(WS_WIN + (size_t)INWP * D * 2 <= WS_WB && WS_BIG + (size_t)M * UW * 2 <= WS_RS && WS_OUTB + (size_t)MAXT * 256 * D * 2 <= WS_RS, "ws map");
constexpr int CW_TMO = 0, CW_CNT = 1024  , CW_BAR = 4096;

constexpr int RING_BYTES = 131072, MISC_OFF = RING_BYTES + 320, LDS_BYTES = 147456;

#define RLX_AGENT __ATOMIC_RELAXED, __HIP_MEMORY_SCOPE_AGENT
#define LDS_WAIT() asm volatile("s_waitcnt lgkmcnt(0)" ::: "memory")
#define VM_WAIT() asm volatile("s_waitcnt vmcnt(0)" ::: "memory")

typedef __bf16 bf16v2 __attribute__((ext_vector_type(2)));
__device__ __forceinline__ unsigned pk2(float lo, float hi) { return __builtin_bit_cast(unsigned, __builtin_convertvector(((f32x2){lo, hi}), bf16v2)); }
__device__ __forceinline__ unsigned f2bf(float f) { return pk2(f, 0.f) & 0xffffu; }
__device__ __forceinline__ float bflo(unsigned w) { return __builtin_bit_cast(float, w << 16); }
__device__ __forceinline__ float bfhi(unsigned w) { return __builtin_bit_cast(float, w & 0xffff0000u); }
__device__ __forceinline__ float bf2f(bf16 b) { return __builtin_bit_cast(float, ((unsigned)b) << 16); }
__device__ __forceinline__ float shx(float v, int o, int lane) { return __builtin_bit_cast(float, __builtin_amdgcn_ds_bpermute((lane ^ o) << 2, __builtin_bit_cast(int, v))); }
__device__ __forceinline__ unsigned shl_u(unsigned v, int src) { return (unsigned)__builtin_amdgcn_ds_bpermute(src << 2, (int)v); }
__device__ __forceinline__ float wave_sum(float v, int lane) {
#pragma unroll
    for (int o = 1; o < 64; o <<= 1) v += shx(v, o, lane);
    return v;
}
__device__ __forceinline__ float half_sum(float v, int lane) {
#pragma unroll
    for (int o = 1; o < 32; o <<= 1) v += shx(v, o, lane);
    return v;
}
__device__ __forceinline__ float sigm(float x) { return __builtin_amdgcn_rcpf(1.f + __expf(-x)); }
typedef _Float16 f16x2_t __attribute__((ext_vector_type(2)));
typedef float f32x2_t __attribute__((ext_vector_type(2)));
__device__ __forceinline__ unsigned pkh2(float a, float b) { return __builtin_bit_cast(unsigned, __builtin_convertvector((f32x2_t){a, b}, f16x2_t)); }
__device__ __forceinline__ float h2lo(unsigned w) { return (float)__builtin_bit_cast(f16x2_t, w).x; }
__device__ __forceinline__ float h2hi(unsigned w) { return (float)__builtin_bit_cast(f16x2_t, w).y; }

#define XB_TMO      128
#define XB_XCNT(j)  (256  + 64 * (j))
#define XB_XSUB(j)  (1280 + 64 * (j))
#define XB_XGEN(j)  (2304 + 64 * (j))
#define XB_TOP      3328
#define XB_TOPGEN   3392
#define XCD_BAR_WORDS 3456
#define XB_SPIN_CAP (1u << 22)
__device__ __forceinline__ unsigned xb_ld(unsigned* p)              { return __hip_atomic_load(p, __ATOMIC_RELAXED, __HIP_MEMORY_SCOPE_AGENT); }
__device__ __forceinline__ unsigned xb_add(unsigned* p, unsigned v) { return __hip_atomic_fetch_add(p, v, __ATOMIC_RELAXED, __HIP_MEMORY_SCOPE_AGENT); }
__device__ __forceinline__ unsigned xb_xcc_id() { return (unsigned)__builtin_amdgcn_s_getreg((3 << 11) | 20) & 0xFu; }
#define XB_SPIN(cond, bar) do { unsigned _sp = 0; while (cond) { __builtin_amdgcn_s_sleep(1); \
    if ((++_sp & 255u) == 0u) { if (xb_ld(&(bar)[XB_TMO])) break; if (_sp > XB_SPIN_CAP) { atomicAdd(&(bar)[XB_TMO], 1u); break; } } } } while (0)
struct XcdBarrier { unsigned* bar; unsigned x; volatile LAS unsigned* st; };
__device__ __forceinline__ XcdBarrier xcd_barrier_post(unsigned* bar, volatile LAS unsigned* st) {
    XcdBarrier b; b.bar = bar; b.x = xb_xcc_id(); b.st = st;
    if (threadIdx.x == 0) (void)xb_add(&bar[XB_XCNT(b.x)], 1u);
    return b;
}
__device__ __forceinline__ void xcd_barrier_complete(unsigned* bar, unsigned x, unsigned& nloc, unsigned& nx) {
    const unsigned G = gridDim.x * gridDim.y * gridDim.z;
    unsigned sum, cnt, mine, sp = 0u;
    for (;;) {
        sum = 0u; cnt = 0u; mine = 0u;
#pragma unroll
        for (unsigned j = 0; j < 16; ++j) { const unsigned c = xb_ld(&bar[XB_XCNT(j)]); sum += c; cnt += (c > 0u) ? 1u : 0u; mine = (j == x) ? c : mine; }
        if (sum == G) break;
        __builtin_amdgcn_s_sleep(1);
        if ((++sp & 255u) == 0u) { if (xb_ld(&bar[XB_TMO])) break; if (sp > XB_SPIN_CAP) { atomicAdd(&bar[XB_TMO], 1u); break; } }
    }
    nloc = mine > 0u ? mine : 1u; nx = cnt > 0u ? cnt : 1u;
}
__device__ __forceinline__ void xcd_barrier(const XcdBarrier& b) {
    asm volatile("s_waitcnt vmcnt(0)" ::: "memory");
    __syncthreads();
    if (threadIdx.x == 0) {
        unsigned* bar = b.bar;
        __builtin_amdgcn_s_waitcnt(0);
        unsigned nloc = b.st[0], nx = b.st[1];
        if (nloc == 0u) { xcd_barrier_complete(bar, b.x, nloc, nx); b.st[0] = nloc; b.st[1] = nx; }
        const unsigned old = xb_add(&bar[XB_XSUB(b.x)], 1u);
        const unsigned gen = old / nloc;
        if (old + 1u == (gen + 1u) * nloc) {
            __builtin_amdgcn_fence(__ATOMIC_RELEASE, "agent");
            asm volatile("s_waitcnt vmcnt(0)" ::: "memory");
            const unsigned og = xb_add(&bar[XB_TOP], 1u);
            const unsigned tg = og / nx;
            if (og + 1u == (tg + 1u) * nx) xb_add(&bar[XB_TOPGEN], 1u);
            else XB_SPIN(xb_ld(&bar[XB_TOPGEN]) == tg, bar);
            __builtin_amdgcn_fence(__ATOMIC_ACQUIRE, "agent");
            xb_add(&bar[XB_XGEN(b.x)], 1u);
            asm volatile("s_waitcnt vmcnt(0)" ::: "memory");
        } else {
            XB_SPIN(xb_ld(&bar[XB_XGEN(b.x)]) == gen, bar);
            __builtin_amdgcn_fence(__ATOMIC_ACQUIRE, "agent");
            asm volatile("s_waitcnt vmcnt(0)" ::: "memory");
        }
    }
    __syncthreads();
}

namespace pg8 {
constexpr int BM = 256, BK = 64, HALF = 128, HTB = HALF * BK * 2, STAGE_BYTES = 8 * HTB, NXCD = 8, WGM = 8;
__host__ __device__ __forceinline__ int lds_byte(int r, int c) { const int st = (r >> 4) * 2 + (c >> 5), rr = r & 15, cc = c & 31, ob = rr * 64 + cc * 2; return st * 1024 + (ob ^ (((ob >> 9) & 1) << 5)); }
__host__ __device__ __forceinline__ void stage_rc(int b, int& R, int& C) { const int st = b / 1024, sb = b % 1024, swz = sb ^ (((sb >> 9) & 1) << 5); R = (st >> 1) * 16 + swz / 64; C = (st & 1) * 32 + (swz % 64) / 2; }
__host__ __device__ __forceinline__ int perm32(int rho) { const int n = rho >> 4, i = rho & 15; return 8 * (i >> 2) + 4 * n + (i & 3); }
struct Unit { int pm, pn, z; };
__device__ __forceinline__ unsigned cvt_pk_bf16(float lo, float hi) { return pk2(lo, hi); }

__device__ __forceinline__ bool static_tile(long L, int nM, int nN, int& pm, int& pn) {
    const int nwg = nM * nN; if (L >= nwg) return false;
    int wgid = (int)L; { const int q = nwg / NXCD, r = nwg % NXCD, xcd = wgid % NXCD, off = wgid / NXCD; wgid = (xcd < r ? xcd * (q + 1) : r * (q + 1) + (xcd - r) * q) + off; }
    const int nig = WGM * nN, gid = wgid / nig, fm = gid * WGM, gsz = (nM - fm) < WGM ? (nM - fm) : WGM;
    pm = fm + ((wgid % nig) % gsz); pn = (wgid % nig) / gsz; return true;
}
struct SchedDense {
    static constexpr bool GATHER = false;
    unsigned A, B, tstep; int nM, nN, G, c;
    __device__ __forceinline__ void init(size_t A_, size_t B_, int M_, int N_, int K_, int G_, int c_) { A = (unsigned)A_; B = (unsigned)B_; tstep = (unsigned)BM * K_ * 2; nM = M_ / BM; nN = N_ / BM; G = G_; c = c_; }
    __device__ __forceinline__ bool next(int i, Unit& u) const { u.z = 0; return static_tile((long)i * G + c, nM, nN, u.pm, u.pn); }
    __device__ __forceinline__ unsigned Ap(const Unit& u) const { return A + (unsigned)u.pm * tstep; }
    __device__ __forceinline__ unsigned Bp(const Unit& u) const { return B + (unsigned)u.pn * tstep; }
};
struct SchedWin {
    static constexpr bool GATHER = false;
    unsigned H, W, Wv, tstep; int n1, G, c, last;
    __device__ __forceinline__ bool next(int i, Unit& u) const { long L = (long)i * G + c;
        if (!last) { if (L < n1) { u.z = 0; return static_tile(L, M / BM, UW / BM, u.pm, u.pn); } L -= n1; }
        else { constexpr int NLAT = (ML / BM) * (UW / BM), NCTX = (MC / BM) * 20;
            if (L < NLAT) { u.z = 0; return static_tile(L, ML / BM, UW / BM, u.pm, u.pn); } L -= NLAT;
            if (L < NCTX) { u.z = 0; const int idx = (int)L % 20; u.pm = ML / BM + (int)L / 20; u.pn = idx < 18 ? 4 + idx : 5 + idx; return true; } L -= NCTX; }
        u.z = 1; return static_tile(L, 1024 / BM, M / BM, u.pm, u.pn); }
    __device__ __forceinline__ unsigned Ap(const Unit& u) const { return H + (unsigned)u.z * (Wv - H) + (unsigned)u.pm * tstep; }
    __device__ __forceinline__ unsigned Bp(const Unit& u) const { return W + (unsigned)u.z * (H - W) + (unsigned)u.pn * tstep; }
};
struct EpiWin {
    static constexpr bool PERM = true, MID = false;
    bf16* Uo; bf16* VT;
    __device__ __forceinline__ void operator()(const f32x4 (&acc)[2][2][4][2], const Unit& u, int wr, int wc, int fr, int fq) const {
        const int row0 = u.pm * BM + wr * 64 + fr, col0 = u.pn * BM + wc * 32 + 8 * fq;
        bf16* O = Uo + (ptrdiff_t)u.z * (VT - Uo); const int ldc = UW + u.z * (M - UW);
#pragma unroll
        for (int ai = 0; ai < 2; ++ai)
#pragma unroll
            for (int m = 0; m < 4; ++m) { bf16* rowp = O + (size_t)(row0 + ai * HALF + m * 16) * ldc + col0;
#pragma unroll
                for (int bj = 0; bj < 2; ++bj) { const f32x4 v0 = acc[ai][bj][m][0], v1 = acc[ai][bj][m][1];
                    u32x4 w; w.x = cvt_pk_bf16(v0[0], v0[1]); w.y = cvt_pk_bf16(v0[2], v0[3]); w.z = cvt_pk_bf16(v1[0], v1[1]); w.w = cvt_pk_bf16(v1[2], v1[3]);
                    *(u32x4*)(rowp + bj * HALF) = w; } }
    }
};
struct SchedSmall {
    static constexpr bool GATHER = false;
    unsigned a0, a1, a2, a3, b0, b1, b2, b3; int G, c;
    __device__ __forceinline__ bool next(int i, Unit& u) const { long L = (long)i * G + c;
        if (L < 1152) { u.z = 0; return static_tile(L, 72, 16, u.pm, u.pn); } L -= 1152;
        if (L < 288) { u.z = 1; return static_tile(L, 72, 4, u.pm, u.pn); } L -= 288;
        if (L < 288) { u.z = 2; return static_tile(L, 72, 4, u.pm, u.pn); } L -= 288;
        u.z = 3; return static_tile(L, 4, 72, u.pm, u.pn); }
    __device__ __forceinline__ unsigned Ap(const Unit& u) const { return a0 + (unsigned)(u.z == 1) * (a1 - a0) + (unsigned)(u.z == 2) * (a2 - a0) + (unsigned)(u.z == 3) * (a3 - a0) + (unsigned)u.pm * (256u * 256 * 2); }
    __device__ __forceinline__ unsigned Bp(const Unit& u) const { return b0 + (unsigned)(u.z == 1) * (b1 - b0) + (unsigned)(u.z == 2) * (b2 - b0) + (unsigned)(u.z == 3) * (b3 - b0) + (unsigned)u.pn * (256u * 256 * 2); }
};
struct EpiSmall {
    static constexpr bool PERM = true, MID = false;
    _Float16* DEC; bf16* AA; const float* w0; const float* a0v; bf16* Gb; bf16* KM; bf16* VTM;
    __device__ __forceinline__ void operator()(const f32x4 (&acc)[2][2][4][2], const Unit& u, int wr, int wc, int fr, int fq) const {
        const int row0 = u.pm * BM + wr * 64 + fr, col0 = u.pn * BM + wc * 32 + 8 * fq;
        if (u.z == 0) {
            if (u.pn < 8) {
#pragma unroll
                for (int bj = 0; bj < 2; ++bj) { const int col = col0 + bj * HALF; const f32x4 b0_ = *(const f32x4*)(w0 + col), b1_ = *(const f32x4*)(w0 + col + 4);
#pragma unroll
                    for (int ai = 0; ai < 2; ++ai)
#pragma unroll
                        for (int m = 0; m < 4; ++m) { const size_t row = (size_t)(row0 + ai * HALF + m * 16); const f32x4 x0 = acc[ai][bj][m][0] + b0_, x1 = acc[ai][bj][m][1] + b1_; f32x4 o0, o1;
#pragma unroll
                            for (int j = 0; j < 4; ++j) { o0[j] = __expf(-0.6065306597126334f * sigm(x0[j]));
                                                          o1[j] = __expf(-0.6065306597126334f * sigm(x1[j])); }
                            u32x4 wq; wq.x = pkh2(o0[0], o0[1]); wq.y = pkh2(o0[2], o0[3]); wq.z = pkh2(o1[0], o1[1]); wq.w = pkh2(o1[2], o1[3]);
                            *(u32x4*)(DEC + row * 2048 + col) = wq; } }
            } else {
#pragma unroll
                for (int bj = 0; bj < 2; ++bj) { const int col = col0 + bj * HALF - 2048; const f32x4 b0_ = *(const f32x4*)(a0v + col), b1_ = *(const f32x4*)(a0v + col + 4);
#pragma unroll
                    for (int ai = 0; ai < 2; ++ai)
#pragma unroll
                        for (int m = 0; m < 4; ++m) { const size_t row = (size_t)(row0 + ai * HALF + m * 16); const f32x4 x0 = acc[ai][bj][m][0] + b0_, x1 = acc[ai][bj][m][1] + b1_;
                            u32x4 w; w.x = pk2(sigm(x0[0]), sigm(x0[1])); w.y = pk2(sigm(x0[2]), sigm(x0[3])); w.z = pk2(sigm(x1[0]), sigm(x1[1])); w.w = pk2(sigm(x1[2]), sigm(x1[3]));
                            *(u32x4*)(AA + row * 2048 + col) = w; } }
            }
        } else {
            bf16* O = Gb + (ptrdiff_t)(u.z == 2) * (KM - Gb) + (ptrdiff_t)(u.z == 3) * (VTM - Gb);
            const int ldc = 1024 + (u.z == 2) * 512 + (u.z == 3) * (M - 1024);
            const int rm = (u.z == 2);
            const int colr = rm ? (col0 >> 6) * 96 + (col0 & 63) : col0, bstep = rm ? 192 : HALF;
#pragma unroll
            for (int ai = 0; ai < 2; ++ai)
#pragma unroll
                for (int m = 0; m < 4; ++m) { bf16* rowp = O + (size_t)(row0 + ai * HALF + m * 16) * ldc + colr;
#pragma unroll
                    for (int bj = 0; bj < 2; ++bj) { const f32x4 v0 = acc[ai][bj][m][0], v1 = acc[ai][bj][m][1];
                        u32x4 w; w.x = cvt_pk_bf16(v0[0], v0[1]); w.y = cvt_pk_bf16(v0[2], v0[3]); w.z = cvt_pk_bf16(v1[0], v1[1]); w.w = cvt_pk_bf16(v1[2], v1[3]);
                        *(u32x4*)(rowp + bj * bstep) = w; } }
        }
    }
};
struct SchedBranch {
    static constexpr bool GATHER = false;
    unsigned A0, A1, A2, B, tstep, zstepB; int nM, nN, G, c;
    __device__ __forceinline__ bool next(int i, Unit& u) const { u.z = i % 3; return static_tile((long)(i / 3) * G + c, nM, nN, u.pm, u.pn); }
    __device__ __forceinline__ unsigned Ap(const Unit& u) const { return (u.z == 0 ? A0 : (u.z == 1 ? A1 : A2)) + (unsigned)u.pm * tstep; }
    __device__ __forceinline__ unsigned Bp(const Unit& u) const { return B + (unsigned)u.z * zstepB + (unsigned)u.pn * tstep; }
};
struct SchedMoe {
    static constexpr bool GATHER = false;
    unsigned A, B, atstep, btstep, estep; const int* tile_e; int ntiles, nN, G, c;
    __device__ __forceinline__ bool next(int i, Unit& u) const { if (!static_tile((long)i * G + c, ntiles, nN, u.pm, u.pn)) return false; u.z = tile_e[u.pm]; return true; }
    __device__ __forceinline__ unsigned Ap(const Unit& u) const { return A + (unsigned)u.pm * atstep; }
    __device__ __forceinline__ unsigned Bp(const Unit& u) const { return B + (unsigned)u.z * estep + (unsigned)u.pn * btstep; }
};

struct SchedMoeG {
    static constexpr bool GATHER = true;
    unsigned A, B, btstep, estep, K2; const int* tile_e; const int* tile_p0; const int* tile_cn; const int* list; int ntiles, nN, G, c;
    __device__ __forceinline__ bool next(int i, Unit& u) const { if (!static_tile((long)i * G + c, ntiles, nN, u.pm, u.pn)) return false; u.z = tile_e[u.pm]; return true; }
    __device__ __forceinline__ unsigned Ap(const Unit&) const { return A; }
    __device__ __forceinline__ unsigned Bp(const Unit& u) const { return B + (unsigned)u.z * estep + (unsigned)u.pn * btstep; }
    __device__ __forceinline__ void arows(const Unit& u, const int (&R)[2], const unsigned (&C2)[2], unsigned (&vo)[2][2]) const {
        const int p0 = tile_p0[u.pm], cn = tile_cn[u.pm]; const int* lp = list + (size_t)u.z * M + p0;
#pragma unroll
        for (int h = 0; h < 2; ++h)
#pragma unroll
            for (int i = 0; i < 2; ++i) { const int p = h * HALF + R[i]; int tok = 0; if (p0 + p < cn) tok = lp[p]; vo[h][i] = (unsigned)tok * K2 + C2[i]; }
    }
};

template <class Epi, class Sched>
__device__ __forceinline__ void gemm_phase(LAS unsigned char* lds, const unsigned char* wsbase, const int K_, const Sched& S, const Epi& E) {
    int tid = threadIdx.x; asm volatile("" : "+v"(tid));
    int K = K_; asm volatile("" : "+s"(K));
    const int wid = __builtin_amdgcn_readfirstlane(tid >> 6), lane = tid & 63, wr = wid >> 2, wc = wid & 3, fr = lane & 15, fq = lane >> 4;
    const int nt = K / BK;
    constexpr bool GA = Sched::GATHER;
    unsigned voffA[2], voffB[2], cv[2][2] = {{0u, 0u}, {0u, 0u}}, nv[2][2] = {{0u, 0u}, {0u, 0u}}; int RA[2]; unsigned CA2[2];
#pragma unroll
    for (int i = 0; i < 2; ++i) { int R, C; stage_rc(tid * 16 + i * 8192, R, C); const int Rb = Epi::PERM ? ((R & ~31) + perm32(R & 31)) : R; RA[i] = R; CA2[i] = (unsigned)C * 2u;
        voffA[i] = (unsigned)(R * K + C) * 2u; voffB[i] = (unsigned)(Rb * K + C) * 2u; }
    const unsigned kstep = (unsigned)(BK * 2);
    const unsigned hstep = (unsigned)HALF * K * 2;
    const unsigned ldsw = (unsigned)wid * 1024u;
    const int aoff = lds_byte(wr * 64 + fr, fq * 8), boff = lds_byte(wc * 32 + fr, fq * 8);
#define PG8_SA(b, h) (((b) * 2 + (h)) * HTB)
#define PG8_SB(b, h) ((4 + (b) * 2 + (h)) * HTB)
#define PG8_STAGE(bufoff, gbase, voff) do { _Pragma("unroll") for (int _i = 0; _i < 2; ++_i) \
        __builtin_amdgcn_global_load_lds((const unsigned*)(wsbase + (size_t)(unsigned)((gbase) + (voff)[_i])), (LAS unsigned*)(lds + (bufoff) + ldsw + _i * 8192), 16, 0, 0); } while (0)
#define PG8_STAGE_A(bufoff, gbase, h, V) do { _Pragma("unroll") for (int _i = 0; _i < 2; ++_i) { const unsigned _o = GA ? (gbase) + (V)[h][_i] : (gbase) + (unsigned)(h) * hstep + voffA[_i]; \
        __builtin_amdgcn_global_load_lds((const unsigned*)(wsbase + (size_t)_o), (LAS unsigned*)(lds + (bufoff) + ldsw + _i * 8192), 16, 0, 0); } } while (0)
#define PG8_LDA(dst, b, h) do { _Pragma("unroll") for (int m = 0; m < 4; ++m) _Pragma("unroll") for (int k = 0; k < 2; ++k) dst[m][k] = *(const LAS bf16x8*)(lds + PG8_SA(b, h) + aoff + m * 2048 + k * 1024); } while (0)
#define PG8_LDB(dst, b, h) do { _Pragma("unroll") for (int n = 0; n < 2; ++n) _Pragma("unroll") for (int k = 0; k < 2; ++k) dst[n][k] = *(const LAS bf16x8*)(lds + PG8_SB(b, h) + boff + n * 2048 + k * 1024); } while (0)
#define PG8_MMA(ai, bj, At, Bt) do { __builtin_amdgcn_s_setprio(1); _Pragma("unroll") for (int m = 0; m < 4; ++m) _Pragma("unroll") for (int n = 0; n < 2; ++n) _Pragma("unroll") for (int k = 0; k < 2; ++k) \
        acc[ai][bj][m][n] = __builtin_amdgcn_mfma_f32_16x16x32_bf16(Bt[n][k], At[m][k], acc[ai][bj][m][n], 0, 0, 0); __builtin_amdgcn_s_setprio(0); } while (0)
#define PG8_WAIT_V(n) asm volatile("s_waitcnt vmcnt(" #n ")" ::: "memory")
#define PG8_WAIT_L(n) asm volatile("s_waitcnt lgkmcnt(" #n ")" ::: "memory")
#define PG8_BAR __builtin_amdgcn_s_barrier()
#define PG8_SCHED __builtin_amdgcn_sched_barrier(0)
    Unit cur, nxt; int ui = 0;
    if (!S.next(0, cur)) return;
    f32x4 acc[2][2][4][2];
#pragma unroll
    for (int a = 0; a < 2; ++a)
#pragma unroll
        for (int b = 0; b < 2; ++b)
#pragma unroll
            for (int m = 0; m < 4; ++m)
#pragma unroll
                for (int n = 0; n < 2; ++n) acc[a][b][m][n] = (f32x4){0.f, 0.f, 0.f, 0.f};
    bf16x8 At[4][2], B0[2][2], B1[2][2];
    unsigned cA = S.Ap(cur), cB = S.Bp(cur);
    if constexpr (GA) { S.arows(cur, RA, CA2, cv); asm volatile("" : "+v"(cv[0][0]), "+v"(cv[0][1]), "+v"(cv[1][0]), "+v"(cv[1][1])); }
    PG8_STAGE(PG8_SB(0, 0), cB, voffB); PG8_STAGE(PG8_SB(0, 1), cB + hstep, voffB); PG8_STAGE_A(PG8_SA(0, 0), cA, 0, cv); PG8_STAGE_A(PG8_SA(0, 1), cA, 1, cv);
    if (wr == 1) PG8_BAR;
    PG8_WAIT_V(2); PG8_BAR;
    PG8_STAGE(PG8_SB(1, 0), cB + kstep, voffB); PG8_STAGE_A(PG8_SA(1, 0), cA + kstep, 0, cv); PG8_STAGE(PG8_SB(1, 1), cB + hstep + kstep, voffB);
    PG8_WAIT_V(6); PG8_BAR;
    for (;;) {
        const bool has_next = S.next(ui + 1, nxt);
        const unsigned nA = has_next ? S.Ap(nxt) : cA, nB = has_next ? S.Bp(nxt) : cB;
        if constexpr (GA) {
            if (has_next) S.arows(nxt, RA, CA2, nv); else { nv[0][0] = cv[0][0]; nv[0][1] = cv[0][1]; nv[1][0] = cv[1][0]; nv[1][1] = cv[1][1]; }
            asm volatile("" : "+v"(nv[0][0]), "+v"(nv[0][1]), "+v"(nv[1][0]), "+v"(nv[1][1])); }
        for (int t = 0; t < nt; t += 2) {
            if constexpr (Epi::MID) { if (t != 0 && (t & 15) == 0) E.mid(acc, cur, t >> 4, wr, wc, fr, fq); }
            const bool last = (t == nt - 2);
            const unsigned a1 = cA + (unsigned)(t + 1) * kstep;
            const unsigned a2 = last ? nA : cA + (unsigned)(t + 2) * kstep, b2 = last ? nB : cB + (unsigned)(t + 2) * kstep;
            const unsigned a3 = a2 + kstep, b3 = b2 + kstep;
            unsigned sv[2][2] = {{0u, 0u}, {0u, 0u}};
            if constexpr (GA) { sv[0][0] = last ? nv[0][0] : cv[0][0]; sv[0][1] = last ? nv[0][1] : cv[0][1]; sv[1][0] = last ? nv[1][0] : cv[1][0]; sv[1][1] = last ? nv[1][1] : cv[1][1]; }
            PG8_LDB(B0, 0, 0); PG8_LDB(B1, 0, 1); PG8_SCHED; PG8_LDA(At, 0, 0); PG8_STAGE_A(PG8_SA(1, 1), a1, 1, cv);
            PG8_WAIT_V(8); PG8_WAIT_L(0); PG8_BAR; PG8_MMA(0, 0, At, B0); PG8_MMA(0, 1, At, B1); PG8_BAR; PG8_SCHED;
            PG8_LDA(At, 0, 1); PG8_STAGE(PG8_SB(0, 0), b2, voffB); PG8_STAGE(PG8_SB(0, 1), b2 + hstep, voffB); PG8_STAGE_A(PG8_SA(0, 0), a2, 0, sv);
            PG8_WAIT_V(8); PG8_WAIT_L(0); PG8_BAR; PG8_MMA(1, 0, At, B0); PG8_MMA(1, 1, At, B1); PG8_BAR; PG8_SCHED;
            PG8_LDB(B0, 1, 0); PG8_LDB(B1, 1, 1); PG8_SCHED; PG8_LDA(At, 1, 0); PG8_STAGE_A(PG8_SA(0, 1), a2, 1, sv);
            PG8_WAIT_V(8); PG8_WAIT_L(0); PG8_BAR; PG8_MMA(0, 0, At, B0); PG8_MMA(0, 1, At, B1); PG8_BAR; PG8_SCHED;
            PG8_LDA(At, 1, 1); PG8_STAGE(PG8_SB(1, 0), b3, voffB); PG8_STAGE(PG8_SB(1, 1), b3 + hstep, voffB); PG8_STAGE_A(PG8_SA(1, 0), a3, 0, sv);
            PG8_WAIT_V(8); PG8_WAIT_L(0); PG8_BAR; PG8_MMA(1, 0, At, B0); PG8_MMA(1, 1, At, B1); PG8_BAR; PG8_SCHED;
        }
        if (wr == 0) PG8_BAR;
        E(acc, cur, wr, wc, fr, fq);
        if (!has_next) break;
#pragma unroll
        for (int a = 0; a < 2; ++a)
#pragma unroll
            for (int b = 0; b < 2; ++b)
#pragma unroll
                for (int m = 0; m < 4; ++m)
#pragma unroll
                    for (int n = 0; n < 2; ++n) acc[a][b][m][n] = (f32x4){0.f, 0.f, 0.f, 0.f};
        cur = nxt; cA = nA; cB = nB; ++ui;
        if constexpr (GA) { cv[0][0] = nv[0][0]; cv[0][1] = nv[0][1]; cv[1][0] = nv[1][0]; cv[1][1] = nv[1][1]; }
        if (wr == 1) PG8_BAR;
    }
    PG8_WAIT_V(0);
    PG8_BAR;
#undef PG8_SA
#undef PG8_SB
#undef PG8_STAGE
#undef PG8_STAGE_A
#undef PG8_LDA
#undef PG8_LDB
#undef PG8_MMA
#undef PG8_WAIT_V
#undef PG8_WAIT_L
#undef PG8_BAR
#undef PG8_SCHED
}

struct EpiStoreBf16 {
    static constexpr bool PERM = true, MID = false;
    bf16* O; int ldc; int remap;
    __device__ __forceinline__ void operator()(const f32x4 (&acc)[2][2][4][2], const Unit& u, int wr, int wc, int fr, int fq) const {
        const int row0 = u.pm * BM + wr * 64 + fr; int col0 = u.pn * BM + wc * 32 + 8 * fq; if (remap) col0 = (col0 >> 6) * 96 + (col0 & 63);
#pragma unroll
        for (int ai = 0; ai < 2; ++ai)
#pragma unroll
            for (int m = 0; m < 4; ++m) { bf16* rowp = O + (size_t)(row0 + ai * HALF + m * 16) * ldc + col0;
#pragma unroll
                for (int bj = 0; bj < 2; ++bj) { const f32x4 v0 = acc[ai][bj][m][0], v1 = acc[ai][bj][m][1];
                    u32x4 w; w.x = cvt_pk_bf16(v0[0], v0[1]); w.y = cvt_pk_bf16(v0[2], v0[3]); w.z = cvt_pk_bf16(v1[0], v1[1]); w.w = cvt_pk_bf16(v1[2], v1[3]);
                    *(u32x4*)(rowp + (remap ? bj * 192 : bj * HALF)) = w; } }
    }
};
struct EpiLoraWA {
    static constexpr bool PERM = false, MID = false;
    float* DEC; bf16* AA; const float* w0; const float* a0;
    __device__ __forceinline__ void operator()(const f32x4 (&acc)[2][2][4][2], const Unit& u, int wr, int wc, int fr, int fq) const {
        const int row0 = u.pm * BM + wr * 64 + fr, col0 = u.pn * BM + wc * 32 + 4 * fq;
        if (u.pn < 8) {
#pragma unroll
            for (int bj = 0; bj < 2; ++bj)
#pragma unroll
                for (int n = 0; n < 2; ++n) { const int col = col0 + bj * HALF + n * 16; const f32x4 bv = *(const f32x4*)(w0 + col);
#pragma unroll
                    for (int ai = 0; ai < 2; ++ai)
#pragma unroll
                        for (int m = 0; m < 4; ++m) { const size_t row = (size_t)(row0 + ai * HALF + m * 16); const f32x4 x = acc[ai][bj][m][n] + bv; f32x4 o;
#pragma unroll
                            for (int j = 0; j < 4; ++j) { const float y = -x[j]; const float sp = fmaxf(y, 0.f) + __logf(1.f + __expf(-fabsf(y))); o[j] = __expf(-__expf(-sp - 0.5f)); }
                            *(f32x4*)(DEC + row * 2048 + col) = o; } }
        } else {
#pragma unroll
            for (int bj = 0; bj < 2; ++bj)
#pragma unroll
                for (int n = 0; n < 2; ++n) { const int col = col0 + bj * HALF + n * 16 - 2048; const f32x4 bv = *(const f32x4*)(a0 + col);
#pragma unroll
                    for (int ai = 0; ai < 2; ++ai)
#pragma unroll
                        for (int m = 0; m < 4; ++m) { const size_t row = (size_t)(row0 + ai * HALF + m * 16); const f32x4 x = acc[ai][bj][m][n] + bv;
                            u32x2 w; w.x = pk2(sigm(x[0]), sigm(x[1])); w.y = pk2(sigm(x[2]), sigm(x[3])); *(u32x2*)(AA + row * 2048 + col) = w; } }
        }
    }
};
struct EpiBranch {
    static constexpr bool PERM = true, MID = true;
    bf16* MB; const bf16* U;
    __device__ __forceinline__ void mid(f32x4 (&acc)[2][2][4][2], const Unit& u, int zb, int wr, int wc, int fr, int fq) const {
        const int row0 = u.pm * BM + wr * 64 + fr, col0 = u.pn * BM + wc * 32 + 8 * fq;
        const bf16* ga = U + O_GATE + (zb - 1) * 2048; const bf16* gb = ga + 2048;
        const unsigned gofs0 = (unsigned)row0 * (unsigned)UW + (unsigned)col0;
#pragma unroll
        for (int ai = 0; ai < 2; ++ai)
#pragma unroll
            for (int mp = 0; mp < 2; ++mp) { u32x4 wa[2][2], wb[2][2];
                asm volatile("" ::: "memory"); unsigned gofs = gofs0; asm volatile("" : "+v"(gofs));
#pragma unroll
                for (int mi = 0; mi < 2; ++mi)
#pragma unroll
                    for (int bj = 0; bj < 2; ++bj) { const size_t o = (size_t)(gofs + (unsigned)(ai * HALF + (2 * mp + mi) * 16) * (unsigned)UW + (unsigned)(bj * HALF)); wa[mi][bj] = *(const u32x4*)(ga + o); wb[mi][bj] = *(const u32x4*)(gb + o); }
#pragma unroll
                for (int mi = 0; mi < 2; ++mi)
#pragma unroll
                    for (int bj = 0; bj < 2; ++bj) { const u32x4 a_ = wa[mi][bj], b_ = wb[mi][bj];
                        const float xa[8] = {bflo(a_.x), bfhi(a_.x), bflo(a_.y), bfhi(a_.y), bflo(a_.z), bfhi(a_.z), bflo(a_.w), bfhi(a_.w)}, xb[8] = {bflo(b_.x), bfhi(b_.x), bflo(b_.y), bfhi(b_.y), bflo(b_.z), bfhi(b_.z), bflo(b_.w), bfhi(b_.w)};
#pragma unroll
                        for (int n = 0; n < 2; ++n)
#pragma unroll
                            for (int j = 0; j < 4; ++j) acc[ai][bj][2 * mp + mi][n][j] *= fminf(1.f + __expf(-xb[4 * n + j]), 1e6f) * __builtin_amdgcn_rcpf(1.f + __expf(-xa[4 * n + j])); } }
    }
    __device__ __forceinline__ void operator()(const f32x4 (&acc)[2][2][4][2], const Unit& u, int wr, int wc, int fr, int fq) const {
        const int row0 = u.pm * BM + wr * 64 + fr, col0 = u.pn * BM + wc * 32 + 8 * fq;
        const bf16* gb = U + O_GATE + 2 * 2048;
        const unsigned gofs0 = (unsigned)row0 * (unsigned)UW + (unsigned)col0, mofs0 = (unsigned)row0 * 2048u + (unsigned)col0;
#pragma unroll
        for (int ai = 0; ai < 2; ++ai) {
            u32x4 wb[4][2];
            asm volatile("" ::: "memory"); unsigned gofs = gofs0, mofs = mofs0; asm volatile("" : "+v"(gofs), "+v"(mofs));
#pragma unroll
            for (int m = 0; m < 4; ++m)
#pragma unroll
                for (int bj = 0; bj < 2; ++bj) wb[m][bj] = *(const u32x4*)(gb + (size_t)(gofs + (unsigned)(ai * HALF + m * 16) * (unsigned)UW + (unsigned)(bj * HALF)));
#pragma unroll
            for (int m = 0; m < 4; ++m)
#pragma unroll
                for (int bj = 0; bj < 2; ++bj) { const u32x4 b_ = wb[m][bj]; const float xb[8] = {bflo(b_.x), bfhi(b_.x), bflo(b_.y), bfhi(b_.y), bflo(b_.z), bfhi(b_.z), bflo(b_.w), bfhi(b_.w)}; float v[8];
#pragma unroll
                    for (int n = 0; n < 2; ++n)
#pragma unroll
                        for (int j = 0; j < 4; ++j) v[4 * n + j] = acc[ai][bj][m][n][j] * __builtin_amdgcn_rcpf(fminf(1.f + __expf(-xb[4 * n + j]), 1e6f));
                    u32x4 w; w.x = cvt_pk_bf16(v[0], v[1]); w.y = cvt_pk_bf16(v[2], v[3]); w.z = cvt_pk_bf16(v[4], v[5]); w.w = cvt_pk_bf16(v[6], v[7]);
                    *(u32x4*)(MB + (size_t)(mofs + (unsigned)(ai * HALF + m * 16) * 2048u + (unsigned)(bj * HALF))) = w; }
        }
    }
};
struct EpiResidual {
    static constexpr bool PERM = false, MID = false;
    float* XR; const float* gate; const float* base_lat; const float* base_ctx;
    __device__ __forceinline__ void operator()(const f32x4 (&acc)[2][2][4][2], const Unit& u, int wr, int wc, int fr, int fq) const {
        const int row0 = u.pm * BM + wr * 64 + fr, col0 = u.pn * BM + wc * 32 + 4 * fq;
        const int rt = u.pm * BM; const int b = rt < ML ? rt / T : 8;
        const float* gp = gate + (size_t)b * 12288 + col0;
        const float* bp = rt < ML ? base_lat : base_ctx - (size_t)ML * D;
        const unsigned xofs0 = (unsigned)row0 * (unsigned)D + (unsigned)col0;
#pragma unroll
        for (int bj = 0; bj < 2; ++bj)
#pragma unroll
            for (int n = 0; n < 2; ++n) { const unsigned dc = (unsigned)(bj * HALF + n * 16); const f32x4 gv = *(const f32x4*)(gp + dc);
                f32x4 bv[2][4];
                asm volatile("" ::: "memory"); unsigned xofs = xofs0; asm volatile("" : "+v"(xofs));
#pragma unroll
                for (int ai = 0; ai < 2; ++ai)
#pragma unroll
                    for (int m = 0; m < 4; ++m) bv[ai][m] = *(const f32x4*)(bp + (size_t)(xofs + (unsigned)(ai * HALF + m * 16) * (unsigned)D + dc));
#pragma unroll
                for (int ai = 0; ai < 2; ++ai)
#pragma unroll
                    for (int m = 0; m < 4; ++m) *(f32x4*)(XR + (size_t)(xofs + (unsigned)(ai * HALF + m * 16) * (unsigned)D + dc)) = bv[ai][m] + gv * acc[ai][bj][m][n]; }
    }
};
struct EpiSwiglu {
    static constexpr bool PERM = true, MID = false;
    bf16* ACT;
    __device__ __forceinline__ void operator()(const f32x4 (&acc)[2][2][4][2], const Unit& u, int wr, int wc, int fr, int fq) const {
        const int row0 = u.pm * BM + wr * 64 + fr, col0 = u.pn * HALF + wc * 32 + 8 * fq;
#pragma unroll
        for (int ai = 0; ai < 2; ++ai)
#pragma unroll
            for (int m = 0; m < 4; ++m) { bf16* rowp = ACT + (size_t)(row0 + ai * HALF + m * 16) * FE + col0;
                f32x4 o0, o1;
#pragma unroll
                for (int j = 0; j < 4; ++j) { const float g0 = acc[ai][0][m][0][j], g1 = acc[ai][0][m][1][j]; o0[j] = g0 * sigm(g0) * acc[ai][1][m][0][j]; o1[j] = g1 * sigm(g1) * acc[ai][1][m][1][j]; }
                u32x4 w; w.x = cvt_pk_bf16(o0[0], o0[1]); w.y = cvt_pk_bf16(o0[2], o0[3]); w.z = cvt_pk_bf16(o1[0], o1[1]); w.w = cvt_pk_bf16(o1[2], o1[3]);
                *(u32x4*)rowp = w; }
    }
};
}

struct Frame {
    LAS unsigned char* lds;
    unsigned* ctl;
    int tid, lane, wave, G, bid;
    float* out;
    unsigned char* ws;
};
__device__ __forceinline__ const float* ld_inp(LAS unsigned char* lds, int i) {
    const volatile LAS unsigned* p = (const volatile LAS unsigned*)(lds + MISC_OFF + 256) + 2 * i;
    const unsigned lo = __builtin_amdgcn_readfirstlane(p[0]), hi = __builtin_amdgcn_readfirstlane(p[1]);
    return (const float*)(const GAS float*)(((unsigned long long)hi << 32) | lo);
}
#define INP(i) ld_inp(F.lds, (i))
#define WSP(T_, off) ((T_*)(F.ws + (off)))

__device__ __forceinline__ void tr_item(const float* W, int ldw, int k0, int n0, bf16* WT, int ldt, int drow0, int dk0, LAS float* scr, int lane) {
#pragma unroll 8
    for (int i = 0; i < 32; ++i) { const int kk = 2 * i + (lane >> 5); scr[kk * 33 + (lane & 31)] = W[(size_t)(k0 + kk) * ldw + n0 + (lane & 31)]; }
    LDS_WAIT();
    const int c = lane & 7;
#pragma unroll
    for (int j = 0; j < 4; ++j) { const int n = (lane >> 3) + 8 * j; const LAS float* s = scr + (8 * c) * 33 + n;
        u32x4 o; o.x = pk2(s[0 * 33], s[1 * 33]); o.y = pk2(s[2 * 33], s[3 * 33]); o.z = pk2(s[4 * 33], s[5 * 33]); o.w = pk2(s[6 * 33], s[7 * 33]);
        *(u32x4*)(WT + (size_t)(drow0 + n) * ldt + dk0 + k0 + 8 * c) = o; }
    LDS_WAIT();
}
__device__ __forceinline__ void convert_weights(Frame& F, int l, const int mask, const int wid, const int nw, const int tw, const int nt) {
    LAS float* scr = (LAS float*)(F.lds + F.wave * 16384);
    constexpr int I_IN = 32 * 422, I_BR = 16 * 64, I_WO = 32 * 64, I_GU = 32 * 64, I_DN = 16 * 64, I_UQ = 8 * 48, I_UKV = 4 * 64, I_LORA = 32;
    constexpr int NITEMS = I_IN + 3 * I_BR + I_WO + 16 * I_GU + 16 * I_DN + I_UQ + I_UKV + 4 * I_LORA;
    for (int it = wid; it < NITEMS; it += nw) {
        int r = it;
        if (r < I_IN) { if (!(mask & 1)) continue; const int kb = r / 422, nb = r % 422; const int n0 = 32 * nb; const int dr = n0 < 2048 ? n0 : (n0 < 3072 ? UW + n0 - 2048 : n0 - 1024);
            tr_item(INP(8) + (size_t)l * D * INW, INW, 64 * kb, n0, WSP(bf16, WS_WIN), D, dr, 0, scr, F.lane); continue; } r -= I_IN;
        if (r < 3 * I_BR) { if (!(mask & 2)) continue; const int z = r / I_BR, q = r % I_BR, kb = q / 64, nb = q % 64; tr_item(INP(25) + (size_t)(l * 3 + z) * 1024 * D, D, 64 * kb, 32 * nb, WSP(bf16, WS_WB), 3072, 32 * nb, z * 1024, scr, F.lane); continue; } r -= 3 * I_BR;
        if (r < I_WO) { if (!(mask & 4)) continue; const int kb = r / 64, nb = r % 64; tr_item(INP(26) + (size_t)l * D * D, D, 64 * kb, 32 * nb, WSP(bf16, WS_WO), D, 32 * nb, 0, scr, F.lane); continue; } r -= I_WO;
        if (r < 16 * I_GU) { if (!(mask & 8)) continue; const int e = r / I_GU, q = r % I_GU, kb = q / 64, nb = q % 64, n0 = 32 * nb; const int bj = n0 >> 10, rem = n0 & 1023, pn = rem >> 7, x0 = rem & 127;
            tr_item(INP(29) + (size_t)(l * NE + e) * D * 2048, 2048, 64 * kb, n0, WSP(bf16, WS_GU) + (size_t)e * 2048 * D, D, pn * 256 + bj * 128 + x0, 0, scr, F.lane); continue; } r -= 16 * I_GU;
        if (r < 16 * I_DN) { if (!(mask & 16)) continue; const int e = r / I_DN, q = r % I_DN, kb = q / 64, nb = q % 64; tr_item(INP(30) + (size_t)(l * NE + e) * FE * D, D, 64 * kb, 32 * nb, WSP(bf16, WS_DN) + (size_t)l * (WS_DN1 - WS_DN) / 2 + (size_t)e * D * FE, FE, 32 * nb, 0, scr, F.lane); continue; } r -= 16 * I_DN;
        if (!(mask & 32)) continue;
        if (r < I_UQ) { const int kb = r / 48, nb = r % 48; tr_item(INP(22) + (size_t)l * 512 * 1536, 1536, 64 * kb, 32 * nb, WSP(bf16, WS_WUQ), 512, 32 * nb, 0, scr, F.lane); continue; } r -= I_UQ;
        if (r < I_UKV) { const int kb = r / 64, nb = r % 64; const int n0 = 32 * nb, c0 = n0 & 127; tr_item(INP(24) + (size_t)l * 256 * 2048, 2048, 64 * kb, n0, WSP(bf16, WS_WUKV), 256, (c0 < 64 ? 0 : 1024) + (n0 >> 7) * 64 + (c0 & 63), 0, scr, F.lane); continue; } r -= I_UKV;
        { const int q4 = r / I_LORA, nb = r % I_LORA;
          const float* src = (q4 < 2 ? INP(12) : INP(14)) + (size_t)((l * 2 + (q4 & 1)) * 64) * 1024;
          tr_item(src, 1024, 0, 32 * nb, WSP(bf16, WS_WA), 256, q4 * 1024 + 32 * nb, q4 * 64, scr, F.lane); }
    }
    if (mask & 32) for (int i = tw; i < 4096 * 24; i += nt) {
        const int n = i / 24, rr = i % 24, ch = rr / 8, p = rr % 8, q = n >> 10; const int kc = ch + (ch >= q ? 1 : 0);
        *(u32x4*)(WSP(bf16, WS_WA) + (size_t)n * 256 + kc * 64 + p * 8) = (u32x4){0u, 0u, 0u, 0u}; }
    const float* gup_ = INP(15);
    if (mask & 32) for (int i = tw; i < 1024 * 256; i += nt) { const int n = i >> 8, k = i & 255; WSP(bf16, WS_WG)[i] = (bf16)(k < 160 ? f2bf(gup_[((size_t)l * 160 + k) * 1024 + n]) : 0u); }
    if (mask & 1) for (int i = tw; i < 64 * D / 8; i += nt) *(u32x4*)(WSP(bf16, WS_WIN) + (size_t)12480 * D + (size_t)i * 8) = (u32x4){0u, 0u, 0u, 0u};
}

__device__ __forceinline__ void mod_phase(Frame& F) {
    LAS float* sc = (LAS float*)F.lds;
    LAS float* red = (LAS float*)(F.lds + 73728);
    const float* c_ = INP(1); const float* cc_ = INP(3); const float* bm_ = INP(5);
    for (int i = F.tid; i < 9 * 2048; i += NTHR) { const int r = i >> 11, k = i & 2047; const float x = r < 8 ? c_[r * 2048 + k] : cc_[k]; sc[i] = x * sigm(x); }
    __syncthreads();
    for (int item = F.bid; item < 256; item += F.G) {
        const int l = item >> 7, n0 = (item & 127) * 96;
        if (F.tid < 384) {
            const int cg = F.tid % 24, kg = F.tid / 24;
            f32x4 a[9];
#pragma unroll
            for (int r = 0; r < 9; ++r) a[r] = (f32x4){0.f, 0.f, 0.f, 0.f};
            const float* wp = INP(4) + ((size_t)l * 2048 + kg * 128) * 12288 + n0 + cg * 4;
            for (int k = 0; k < 128; ++k) { const f32x4 w = *(const f32x4*)(wp + (size_t)k * 12288);
#pragma unroll
                for (int r = 0; r < 9; ++r) a[r] += w * sc[r * 2048 + kg * 128 + k]; }
#pragma unroll
            for (int r = 0; r < 9; ++r) *(LAS f32x4*)(red + (kg * 9 + r) * 96 + cg * 4) = a[r];
        }
        __syncthreads();
        for (int o = F.tid; o < 9 * 96; o += NTHR) { const int r = o / 96, c = o % 96; float s = bm_[l * 12288 + n0 + c];
#pragma unroll
            for (int kg = 0; kg < 16; ++kg) s += red[(kg * 9 + r) * 96 + c];
            WSP(float, WS_MODF)[((size_t)l * 9 + r) * 12288 + n0 + c] = s; }
        __syncthreads();
    }
}

__device__ __forceinline__ void norm_mod_store(const f32x4 (&v)[8], int lane, const float* g, const float* sc, const float* sh, bf16* orow) {
    float ss = 0.f;
#pragma unroll
    for (int j = 0; j < 8; ++j) ss += (v[j].x * v[j].x + v[j].y * v[j].y) + (v[j].z * v[j].z + v[j].w * v[j].w);
    const float rinv = rsqrtf(wave_sum(ss, lane) * (1.f / D) + 1e-6f);
#pragma unroll
    for (int j = 0; j < 8; ++j) { const int c4 = lane + 64 * j; const f32x4 gv = ((const f32x4*)g)[c4], scv = ((const f32x4*)sc)[c4], shv = ((const f32x4*)sh)[c4];
        const f32x4 h = (v[j] * rinv) * gv * (scv + 1.0f) + shv;
        u32x2 w; w.x = pk2(h.x, h.y); w.y = pk2(h.z, h.w); ((u32x2*)orow)[c4] = w; }
}

__device__ __forceinline__ float rope_inv(int i) { return __expf(-(float)i * (9.210340371976184f / 8.0f)); }

typedef short bf16x4 __attribute__((ext_vector_type(4)));
__device__ __forceinline__ bf16x4 pk4(f32x4 v) { u32x2 w; w.x = pg8::cvt_pk_bf16(v[0], v[1]); w.y = pg8::cvt_pk_bf16(v[2], v[3]); return __builtin_bit_cast(bf16x4, w); }
__device__ __forceinline__ f32x4 up4(bf16x4 b) { const u32x2 w = __builtin_bit_cast(u32x2, b); return (f32x4){bflo(w.x), bfhi(w.x), bflo(w.y), bfhi(w.y)}; }
#define MFMA16(a, b, c) __builtin_amdgcn_mfma_f32_16x16x16bf16_1k((a), (b), (c), 0, 0, 0)
constexpr int SC_P = 136;
constexpr int SL_KH = 0, SL_RH = 2176, SL_KDT = 4352, SL_BHT = 6400, SL_VT = 8448, SL_A1T = 10496, SL_X = 11008, SL_M1T = 11520, SL_M2T = 12032, SL_GC = 12544, SL_BYTES = 12800;
constexpr int SC_NS = 6;
constexpr int PV_BH = 0, PV_KDH = 2176, PV_L = 4352, PV_BYTES = 5632;
constexpr int SC_PRIV = SC_NS * SL_BYTES, SC_FLAGS = SC_PRIV + 4 * PV_BYTES;
constexpr unsigned SC_SPIN_CAP = 1u << 22;
__device__ __forceinline__ void scan_chain(LAS unsigned char* lds, const int tid, const int l, const int ch, const bf16* RS, const bf16* KS, const bf16* VS, const bf16* KKp, const _Float16* DEC, const bf16* AA,
                                           const float* kap, bf16* YSbase) {
    const int lane = tid & 63, q = __builtin_amdgcn_readfirstlane(tid >> 6), lr = lane & 15, lg = lane >> 4;
    const int z = ch >> 7, b = (ch >> 4) & 7, h = ch & 15;
    constexpr int NCH = (TC + T) / 16;
    volatile LAS int* rdy = (volatile LAS int*)(lds + SC_FLAGS); volatile LAS int* sprog = (volatile LAS int*)(lds + SC_FLAGS + 32);
    if (tid < 16) ((LAS int*)(lds + SC_FLAGS))[tid] = 0;
    __syncthreads();
    auto row0_of = [&](int c) { const int step = 16 * c; return step < TC ? ML + b * TC + (z ? TC - 1 - step : step) : b * T + (z ? T - 1 - (step - TC) : (step - TC)); };
    const int dr = z ? -1 : 1;
    if (q >= 4) {
        const int pw = q - 4;
        LAS unsigned char* PV = lds + SC_PRIV + pw * PV_BYTES;
        const int cp = lane & 31, shf = lane >> 5;
        const f32x2 ka2 = *(const f32x2*)(kap + h * 64 + 2 * cp);
        unsigned rw[8], pa[8], pr[8], pkk[8], pk[8], pv[8];
        auto pload = [&](int c) { const int r0 = row0_of(c) + dr * 8 * shf;
            const long o1 = (long)r0 * 1024 + h * 64 + 2 * cp, o2 = (long)r0 * 2048 + z * 1024 + h * 64 + 2 * cp; const long s1 = (long)dr * 1024, s2 = (long)dr * 2048;
#pragma unroll
            for (int j = 0; j < 8; ++j) { rw[j] = *(const unsigned*)(DEC + o2 + j * s2); pa[j] = *(const unsigned*)(AA + o2 + j * s2); pr[j] = *(const unsigned*)(RS + o1 + j * s1);
                pkk[j] = *(const unsigned*)(KKp + o1 + j * s1); pk[j] = *(const unsigned*)(KS + o1 + j * s1); pv[j] = *(const unsigned*)(VS + o1 + j * s1); } };
        if (pw < NCH) pload(pw);
        for (int c = pw; c < NCH; c += 4) {
            LAS unsigned char* SB = lds + (c % SC_NS) * SL_BYTES;
            if (c >= SC_NS) { const int need = c - SC_NS + 1; unsigned sp = 0;
                for (;;) { const int a0 = sprog[0], a1 = sprog[1], a2 = sprog[2], a3 = sprog[3]; const int mn = min(min(a0, a1), min(a2, a3)); if (mn >= need || ++sp > SC_SPIN_CAP) break; __builtin_amdgcn_s_sleep(1); } }
            asm volatile("" ::: "memory");
            { float g0 = 1.f, g1 = 1.f;
#pragma unroll
              for (int j = 0; j < 8; ++j) { g0 *= h2lo(rw[j]); g1 *= h2hi(rw[j]); }
              const float o0 = shx(g0, 32, lane), o1_ = shx(g1, 32, lane);
              g0 = shf ? o0 : 1.f; g1 = shf ? o1_ : 1.f;
              unsigned kdq0[4], kdq1[4], bq0[4], bq1[4];
              float kd0p = 0.f, kd1p = 0.f, b0p = 0.f, b1p = 0.f;
#pragma unroll
              for (int j = 0; j < 8; ++j) { const int t = 8 * shf + j; const float gp0 = g0, gp1 = g1; g0 *= h2lo(rw[j]); g1 *= h2hi(rw[j]);
                  const float kk0 = bflo(pkk[j]), kk1 = bfhi(pkk[j]), a0 = bflo(pa[j]), a1 = bfhi(pa[j]); const float i0 = __builtin_amdgcn_rcpf(g0), i1 = __builtin_amdgcn_rcpf(g1);
                  const float bh0 = kk0 * a0 * i0, bh1 = kk1 * a1 * i1, kd0 = bflo(pk[j]) * (1.f + (a0 - 1.f) * ka2.x) * i0, kd1 = bfhi(pk[j]) * (1.f + (a1 - 1.f) * ka2.y) * i1;
                  *(LAS unsigned*)(SB + SL_KH + t * SC_P + cp * 4) = pk2(kk0 * gp0, kk1 * gp1); *(LAS unsigned*)(SB + SL_RH + t * SC_P + cp * 4) = pk2(bflo(pr[j]) * g0, bfhi(pr[j]) * g1);
                  *(LAS unsigned*)(PV + PV_BH + t * SC_P + cp * 4) = pk2(bh0, bh1); *(LAS unsigned*)(PV + PV_KDH + t * SC_P + cp * 4) = pk2(kd0, kd1);
                  if (j & 1) { kdq0[j >> 1] = pk2(kd0p, kd0); kdq1[j >> 1] = pk2(kd1p, kd1); bq0[j >> 1] = pk2(b0p, bh0); bq1[j >> 1] = pk2(b1p, bh1); } else { kd0p = kd0; kd1p = kd1; b0p = bh0; b1p = bh1; } }
              if (shf) *(LAS f32x2*)(SB + SL_GC + cp * 8) = (f32x2){g0, g1};
              *(LAS u32x4*)(SB + SL_KDT + (2 * cp) * 32 + shf * 16) = (u32x4){kdq0[0], kdq0[1], kdq0[2], kdq0[3]}; *(LAS u32x4*)(SB + SL_KDT + (2 * cp + 1) * 32 + shf * 16) = (u32x4){kdq1[0], kdq1[1], kdq1[2], kdq1[3]};
              *(LAS u32x4*)(SB + SL_BHT + (2 * cp) * 32 + shf * 16) = (u32x4){bq0[0], bq0[1], bq0[2], bq0[3]}; *(LAS u32x4*)(SB + SL_BHT + (2 * cp + 1) * 32 + shf * 16) = (u32x4){bq1[0], bq1[1], bq1[2], bq1[3]};
              u32x4 v0_, v1_;
#pragma unroll
              for (int m = 0; m < 4; ++m) { v0_[m] = (pv[2 * m] & 0xffffu) | (pv[2 * m + 1] << 16); v1_[m] = (pv[2 * m] >> 16) | (pv[2 * m + 1] & 0xffff0000u); }
              *(LAS u32x4*)(SB + SL_VT + (2 * cp) * 32 + shf * 16) = v0_; *(LAS u32x4*)(SB + SL_VT + (2 * cp + 1) * 32 + shf * 16) = v1_; }
            if (c + 4 < NCH) pload(c + 4);
            LDS_WAIT();
#pragma unroll
            for (int gi = 0; gi < 4; ++gi) {
                const LAS unsigned char* Aarr = PV + ((gi & 1) ? PV_KDH : PV_BH); const LAS unsigned char* Barr = SB + ((gi < 2) ? SL_KH : SL_RH);
                f32x4 acc = (f32x4){0.f, 0.f, 0.f, 0.f};
#pragma unroll
                for (int kt = 0; kt < 4; ++kt) acc = MFMA16(*(const LAS bf16x4*)(Aarr + lr * SC_P + (16 * kt + 4 * lg) * 2), *(const LAS bf16x4*)(Barr + lr * SC_P + (16 * kt + 4 * lg) * 2), acc);
#pragma unroll
                for (int i = 0; i < 4; ++i) { const int j = 4 * lg + i; const bool keep = (gi < 2) ? (j < lr) : (j <= lr); acc[i] = keep ? acc[i] : 0.f; }
                if (gi == 0) {
#pragma unroll
                    for (int i = 0; i < 4; ++i) *(LAS float*)(PV + PV_L + (4 * lg + i) * 64 + lr * 4) = acc[i]; }
                else *(LAS bf16x4*)(SB + (gi == 1 ? SL_A1T : (gi == 2 ? SL_M2T : SL_M1T)) + lr * 32 + lg * 8) = pk4(acc);
            }
            LDS_WAIT();
            { float X[16];
#pragma unroll
              for (int t = 0; t < 16; ++t) X[t] = (t == lr) ? 1.f : 0.f;
#pragma unroll
              for (int j = 0; j < 15; ++j) {
                  f32x4 aq[4];
#pragma unroll
                  for (int tq = (j + 1) >> 2; tq < 4; ++tq) aq[tq] = *(const LAS f32x4*)(PV + PV_L + j * 64 + tq * 16);
#pragma unroll
                  for (int t = j + 1; t < 16; ++t) X[t] -= aq[t >> 2][t & 3] * X[j];
              }
              if (lane < 16) {
#pragma unroll
                  for (int t = 0; t < 16; ++t) *(LAS bf16*)(SB + SL_X + t * 32 + lr * 2) = (bf16)f2bf(X[t]); } }
            LDS_WAIT();
            if (lane == 0) rdy[c % SC_NS] = c + 1;
        }
    } else {
        bf16* YS = YSbase + (size_t)z * M * 1024 + h * 64 + 16 * q + lr;
        f32x4 S[4];
#pragma unroll
        for (int kt = 0; kt < 4; ++kt) S[kt] = (f32x4){0.f, 0.f, 0.f, 0.f};
        for (int c = 0; c < NCH; ++c) {
            const LAS unsigned char* SB = lds + (c % SC_NS) * SL_BYTES;
            { unsigned sp = 0; while (rdy[c % SC_NS] != c + 1 && ++sp <= SC_SPIN_CAP) __builtin_amdgcn_s_sleep(1); }
            asm volatile("" ::: "memory");
            bf16x4 hi[4], lo[4];
#pragma unroll
            for (int kt = 0; kt < 4; ++kt) { hi[kt] = pk4(S[kt]); lo[kt] = pk4(S[kt] - up4(hi[kt])); }
            f32x4 g4 = (f32x4){0.f, 0.f, 0.f, 0.f}, yq = (f32x4){0.f, 0.f, 0.f, 0.f};
#pragma unroll
            for (int kt = 0; kt < 4; ++kt) { const bf16x4 ak = *(const LAS bf16x4*)(SB + SL_KH + lr * SC_P + (16 * kt + 4 * lg) * 2), ar = *(const LAS bf16x4*)(SB + SL_RH + lr * SC_P + (16 * kt + 4 * lg) * 2);
                g4 = MFMA16(ak, hi[kt], g4); g4 = MFMA16(ak, lo[kt], g4); yq = MFMA16(ar, hi[kt], yq); yq = MFMA16(ar, lo[kt], yq); }
            const bf16x4 vt = *(const LAS bf16x4*)(SB + SL_VT + (16 * q + lr) * 32 + lg * 8);
            const f32x4 hT = MFMA16(*(const LAS bf16x4*)(SB + SL_A1T + lr * 32 + lg * 8), vt, g4);
            const bf16x4 hb = pk4(hT), hl = pk4(hT - up4(hb));
            const bf16x4 xf = *(const LAS bf16x4*)(SB + SL_X + lr * 32 + lg * 8);
            f32x4 uT = MFMA16(xf, hb, ((f32x4){0.f, 0.f, 0.f, 0.f})); uT = MFMA16(xf, hl, uT);
            const u32x2 ubw = __builtin_bit_cast(u32x2, pk4(uT));
            const bf16x4 nub = __builtin_bit_cast(bf16x4, ((u32x2){ubw.x ^ 0x80008000u, ubw.y ^ 0x80008000u}));
            f32x4 yT = MFMA16(*(const LAS bf16x4*)(SB + SL_M1T + lr * 32 + lg * 8), vt, yq);
            yT = MFMA16(*(const LAS bf16x4*)(SB + SL_M2T + lr * 32 + lg * 8), nub, yT);
            { const long yo = (long)row0_of(c) * 1024, ys = (long)dr * 1024;
#pragma unroll
              for (int i = 0; i < 4; ++i) YS[yo + (4 * lg + i) * ys] = (bf16)f2bf(yT[i]); }
#pragma unroll
            for (int kt = 0; kt < 4; ++kt) {
                S[kt] = MFMA16(*(const LAS bf16x4*)(SB + SL_KDT + (16 * kt + lr) * 32 + lg * 8), vt, S[kt]);
                S[kt] = MFMA16(*(const LAS bf16x4*)(SB + SL_BHT + (16 * kt + lr) * 32 + lg * 8), nub, S[kt]);
                S[kt] = S[kt] * *(const LAS f32x4*)(SB + SL_GC + (16 * kt + 4 * lg) * 4); }
            LDS_WAIT();
            if (lane == 0) sprog[q] = c + 1;
        }
    }
}

typedef float f32x16 __attribute__((ext_vector_type(16)));
constexpr int ATT_VP = 136, ATT_VBYTES = 64 * ATT_VP, ATT_RPB_OFF = 49152;
template <int DQK, int MODE>
__device__ __forceinline__ void attn_unit(LAS unsigned char* lds, const int tid, const bf16* Qp, const int qpitch, const float qscale, const int tq0,
                                          const bf16* Kp, const int kpitch, const bf16* VTp, const int vtpitch, const int nA, const int tA, const int nB, const int tB, bf16* Op,
                                          const float* rpb_h, const int i0, const int rlo) {
    constexpr int KP = DQK * 2 + 16, KBYTES = 64 * KP, CPR = DQK / 8, NKS = DQK / 16;
    constexpr int VOFF = 2 * KBYTES;
    const int lane = tid & 63, w = __builtin_amdgcn_readfirstlane(tid >> 6), c = lane & 31, hf = lane >> 5;
    LAS float* RPB = (LAS float*)(lds + ATT_RPB_OFF);
    if (MODE == 2) { for (int i = tid; i < 15 * 31; i += NTHR) RPB[i] = rpb_h[i] * 1.4426950408889634f; }
    bf16x8 qf[NKS];
    {
        const bf16* qrow = Qp + (size_t)(32 * w + c) * qpitch;
        const int tq = tq0 + 32 * w + c;
#pragma unroll
        for (int ks = 0; ks < NKS; ++ks) {
            const u32x4 raw = *(const u32x4*)(qrow + 16 * ks + 8 * hf);
            float f[8] = {bflo(raw.x), bfhi(raw.x), bflo(raw.y), bfhi(raw.y), bflo(raw.z), bfhi(raw.z), bflo(raw.w), bfhi(raw.w)};
            if (MODE == 1 && ks >= 4) {
                const float pos = (float)(ks == 4 ? (tq >> 6) : (tq & 63));
#pragma unroll
                for (int j = 0; j < 8; ++j) { const float p = shx(f[j], 32, lane); const float ang = pos * rope_inv(j); const float sn = __sinf(ang), cs = __cosf(ang); f[j] = hf ? (p * sn + f[j] * cs) : (f[j] * cs - p * sn); }
            }
            u32x4 o; o.x = pk2(f[0] * qscale, f[1] * qscale); o.y = pk2(f[2] * qscale, f[3] * qscale); o.z = pk2(f[4] * qscale, f[5] * qscale); o.w = pk2(f[6] * qscale, f[7] * qscale);
            qf[ks] = __builtin_bit_cast(bf16x8, o);
        }
    }
    const int jq = (32 * w + c) & 63, iw = i0 + (w >> 1);
    int r0w = iw - 4; r0w = r0w < 0 ? 0 : (r0w > 24 ? 24 : r0w);
    int cs0 = jq - 8; cs0 = cs0 < 0 ? 0 : (cs0 > 48 ? 48 : cs0);
    const int krow = tid / CPR, kcc = tid % CPR, krow2 = (tid + 512) / CPR, kcc2 = (tid + 512) % CPR, vdv = tid >> 3, vcc = tid & 7;
    u32x4 pk0[2], pk1[2], pv[2];
    int ntl = nA + nB; asm volatile("" : "+s"(ntl));
#define ATT_GLOAD(t_, S_) do { const int T0_ = (t_) < nA ? tA + 64 * (t_) : tB + 64 * ((t_) - nA); \
        pk0[S_] = *(const u32x4*)(Kp + (size_t)(T0_ + krow) * kpitch + kcc * 8); \
        if (DQK == 96 && tid < 256) pk1[S_] = *(const u32x4*)(Kp + (size_t)(T0_ + krow2) * kpitch + kcc2 * 8); \
        pv[S_] = *(const u32x4*)(VTp + (size_t)vdv * vtpitch + T0_ + vcc * 8); } while (0)
#define ATT_LSTORE(buf_, S_) do { \
        *(LAS u32x4*)(lds + (buf_) * KBYTES + krow * KP + kcc * 16) = pk0[S_]; \
        if (DQK == 96 && tid < 256) *(LAS u32x4*)(lds + (buf_) * KBYTES + krow2 * KP + kcc2 * 16) = pk1[S_]; \
        LAS u32x2* vd_ = (LAS u32x2*)(lds + VOFF + (buf_) * ATT_VBYTES + vdv * ATT_VP + vcc * 16); vd_[0] = (u32x2){pv[S_].x, pv[S_].y}; vd_[1] = (u32x2){pv[S_].z, pv[S_].w}; } while (0)
    float m = -1e30f, lsum = 0.f;
    f32x16 o0, o1;
#pragma unroll
    for (int r = 0; r < 16; ++r) { o0[r] = 0.f; o1[r] = 0.f; }
    auto compute = [&](const int t, const int buf) {
        const int kr = rlo + t;
        const bool active = (MODE != 2) || (t >= nA) || (kr >= r0w && kr < r0w + 8);
        if (active) {
            const LAS unsigned char* KL = lds + buf * KBYTES; const LAS unsigned char* VL = lds + VOFF + buf * ATT_VBYTES;
            f32x16 s0, s1;
#pragma unroll
            for (int r = 0; r < 16; ++r) { s0[r] = 0.f; s1[r] = 0.f; }
#pragma unroll
            for (int ks = 0; ks < NKS; ++ks) {
                const bf16x8 k0 = *(const LAS bf16x8*)(KL + c * KP + (16 * ks + 8 * hf) * 2);
                const bf16x8 k1 = *(const LAS bf16x8*)(KL + (32 + c) * KP + (16 * ks + 8 * hf) * 2);
                s0 = __builtin_amdgcn_mfma_f32_32x32x16_bf16(k0, qf[ks], s0, 0, 0, 0);
                s1 = __builtin_amdgcn_mfma_f32_32x32x16_bf16(k1, qf[ks], s1, 0, 0, 0);
            }
            if (MODE == 2 && t < nA) {
                const LAS float* rb = RPB + (kr - iw + 7) * 31 + 15 - jq;
                { float bb[16];
#pragma unroll
                  for (int r = 0; r < 16; ++r) bb[r] = rb[(r & 3) + 8 * (r >> 2) + 4 * hf];
#pragma unroll
                  for (int r = 0; r < 16; ++r) asm volatile("" : "+v"(bb[r]));
#pragma unroll
                  for (int r = 0; r < 16; ++r) { const int kc = (r & 3) + 8 * (r >> 2) + 4 * hf; s0[r] = ((kc >= cs0) && (kc < cs0 + 16)) ? s0[r] + bb[r] : -1e30f; } }
                { float bb[16];
#pragma unroll
                  for (int r = 0; r < 16; ++r) bb[r] = rb[32 + (r & 3) + 8 * (r >> 2) + 4 * hf];
#pragma unroll
                  for (int r = 0; r < 16; ++r) asm volatile("" : "+v"(bb[r]));
#pragma unroll
                  for (int r = 0; r < 16; ++r) { const int kc = 32 + (r & 3) + 8 * (r >> 2) + 4 * hf; s1[r] = ((kc >= cs0) && (kc < cs0 + 16)) ? s1[r] + bb[r] : -1e30f; } }
            }
            float mx = s0[0];
#pragma unroll
            for (int r = 1; r < 16; ++r) mx = fmaxf(mx, s0[r]);
#pragma unroll
            for (int r = 0; r < 16; ++r) mx = fmaxf(mx, s1[r]);
            mx = fmaxf(mx, shx(mx, 32, lane));
            const float mn = (mx > m + 8.f) ? mx : m, alpha = __builtin_amdgcn_exp2f(m - mn);
            m = mn;
            float rs = 0.f;
#pragma unroll
            for (int r = 0; r < 16; ++r) { s0[r] = __builtin_amdgcn_exp2f(s0[r] - mn); s1[r] = __builtin_amdgcn_exp2f(s1[r] - mn); rs += s0[r] + s1[r]; }
            lsum = lsum * alpha + rs;
            if (__any(alpha != 1.f)) {
#pragma unroll
                for (int r = 0; r < 16; ++r) { o0[r] *= alpha; o1[r] *= alpha; } }
            bf16x8 pf[2][2];
#pragma unroll
            for (int st = 0; st < 2; ++st) {
                u32x4 a; a.x = pk2(s0[8 * st + 0], s0[8 * st + 1]); a.y = pk2(s0[8 * st + 2], s0[8 * st + 3]); a.z = pk2(s0[8 * st + 4], s0[8 * st + 5]); a.w = pk2(s0[8 * st + 6], s0[8 * st + 7]);
                u32x4 b; b.x = pk2(s1[8 * st + 0], s1[8 * st + 1]); b.y = pk2(s1[8 * st + 2], s1[8 * st + 3]); b.z = pk2(s1[8 * st + 4], s1[8 * st + 5]); b.w = pk2(s1[8 * st + 6], s1[8 * st + 7]);
                pf[0][st] = __builtin_bit_cast(bf16x8, a); pf[1][st] = __builtin_bit_cast(bf16x8, b);
            }
#pragma unroll
            for (int kb = 0; kb < 2; ++kb)
#pragma unroll
                for (int st = 0; st < 2; ++st) {
                    const int ko = (32 * kb + 16 * st + 4 * hf) * 2;
                    const u32x2 a0 = *(const LAS u32x2*)(VL + c * ATT_VP + ko), a1 = *(const LAS u32x2*)(VL + c * ATT_VP + ko + 16);
                    const u32x2 b0 = *(const LAS u32x2*)(VL + (32 + c) * ATT_VP + ko), b1 = *(const LAS u32x2*)(VL + (32 + c) * ATT_VP + ko + 16);
                    const bf16x8 v0 = __builtin_bit_cast(bf16x8, (u32x4){a0.x, a0.y, a1.x, a1.y}), v1 = __builtin_bit_cast(bf16x8, (u32x4){b0.x, b0.y, b1.x, b1.y});
                    o0 = __builtin_amdgcn_mfma_f32_32x32x16_bf16(v0, pf[kb][st], o0, 0, 0, 0);
                    o1 = __builtin_amdgcn_mfma_f32_32x32x16_bf16(v1, pf[kb][st], o1, 0, 0, 0);
                }
        }
    };
    ATT_GLOAD(0, 0); ATT_LSTORE(0, 0);
    if (ntl > 1) ATT_GLOAD(1, 1);
    __syncthreads();
    for (int t = 0; t < ntl; t += 2) {
        if (t + 2 < ntl) ATT_GLOAD(t + 2, 0);
        compute(t, 0);
        if (t + 1 < ntl) ATT_LSTORE(1, 1);
        __syncthreads();
        if (t + 1 >= ntl) break;
        if (t + 3 < ntl) ATT_GLOAD(t + 3, 1);
        compute(t + 1, 1);
        if (t + 2 < ntl) ATT_LSTORE(0, 0);
        __syncthreads();
    }
#undef ATT_GLOAD
#undef ATT_LSTORE
    lsum += shx(lsum, 32, lane);
    const float inv = __builtin_amdgcn_rcpf(lsum);
    bf16* orow = Op + (size_t)(32 * w + c) * 3072;
#pragma unroll
    for (int g = 0; g < 4; ++g) {
        u32x2 a; a.x = pk2(o0[4 * g] * inv, o0[4 * g + 1] * inv); a.y = pk2(o0[4 * g + 2] * inv, o0[4 * g + 3] * inv);
        u32x2 b; b.x = pk2(o1[4 * g] * inv, o1[4 * g + 1] * inv); b.y = pk2(o1[4 * g + 2] * inv, o1[4 * g + 3] * inv);
        *(u32x2*)(orow + 8 * g + 4 * hf) = a; *(u32x2*)(orow + 32 + 8 * g + 4 * hf) = b;
    }
}

struct Args { const float* in[32]; float* out; unsigned char* ws; int ph_lo, ph_hi; };

template <unsigned PM>
__global__ void __launch_bounds__(NTHR, 2) fwd_kernel(Args args) {
    extern __shared__ __attribute__((aligned(16))) unsigned char lds_raw[];
    LAS unsigned char* const lds0 = (LAS unsigned char*)lds_raw;
    unsigned char* const ws0 = args.ws; float* const out0 = args.out;
    {
        const int t0 = threadIdx.x;
        for (int u = t0; u < (LDS_BYTES - RING_BYTES) / 4; u += NTHR) ((LAS unsigned*)(lds0 + RING_BYTES))[u] = 0u;
        __syncthreads();
        if (t0 == 0) {
#pragma unroll
            for (int i = 0; i < 32; ++i) ((volatile LAS unsigned long long*)(lds0 + MISC_OFF + 256))[i] = (unsigned long long)args.in[i];
        }
        __syncthreads();
    }
    const int lo = args.ph_lo, hi = args.ph_hi;
    XcdBarrier bar; bar.bar = (unsigned*)(ws0 + WS_CTL) + CW_BAR; bar.x = 0; bar.st = nullptr;
    if (hi - lo > 1) bar = xcd_barrier_post((unsigned*)(ws0 + WS_CTL) + CW_BAR, (volatile LAS unsigned*)(lds0 + MISC_OFF) + 8);
#define IN(k) (lo <= (k) && (k) < hi)
#define SEAM(k) do { if (IN(k) && IN((k) + 1)) { XcdBarrier b2 = bar; asm volatile("" : "+s"(b2.bar)); xcd_barrier(b2); } } while (0)
#define FRAME() Frame F; { int tz = threadIdx.x; asm volatile("" : "+v"(tz)); size_t zo = 0; asm volatile("" : "+s"(zo)); unsigned char* wz = ws0 + zo; \
    F.lds = lds0; F.tid = tz; F.lane = tz & 63; F.wave = __builtin_amdgcn_readfirstlane(tz >> 6); F.G = gridDim.x; F.bid = blockIdx.x; F.out = out0; F.ws = wz; F.ctl = (unsigned*)(wz + WS_CTL); } \
    const int gw = F.bid * NWAVES + F.wave, NGW = F.G * NWAVES, lane = F.lane; (void)gw; (void)NGW; (void)lane

    if (PHEN(0) && IN(0)) REPL(0) {
        FRAME();
        mod_phase(F);
        convert_weights(F, 0, 63, F.bid * NWAVES + F.wave, F.G * NWAVES, F.bid * NTHR + F.tid, F.G * NTHR);
    }
    SEAM(0);

    for (int l = 0; l < 2; ++l) {
        const int pb = 1 + l * PH_PER_LAYER;
        const int Mrows = (l == 0) ? M : ML;

        if (PHEN(1) && IN(pb + 0) && l == 0) {
            FRAME();
            const float* MODL = WSP(float, WS_MODF) + (size_t)l * 9 * 12288; (void)MODL;
            const float* n1g_ = INP(6) + l * D; const float* xin_ = INP(0); const float* cin_ = INP(2);
            {
              const float* rwp = INP(27); const float* n2g = INP(7); bf16* WRB = WSP(bf16, WS_WRB); float* CB = WSP(float, WS_CB);
              for (int i = F.bid * NTHR + F.tid; i < 2 * 9 * 16 * D; i += F.G * NTHR) { const int k = i & 2047, e = (i >> 11) & 15, lb = i >> 15, b2 = lb % 9, l2 = lb / 9;
                  const float* md = WSP(float, WS_MODF) + ((size_t)l2 * 9 + b2) * 12288;
                  const float w = n2g[l2 * D + k] * (1.f + md[8192 + k]) * rwp[(size_t)k * 16 + e]; const unsigned hi = f2bf(w);
                  bf16* dst = WRB + ((size_t)lb * 2 * 16 + e) * D + k; dst[0] = (bf16)hi; dst[16 * D] = (bf16)f2bf(w - bf2f((bf16)hi)); }
              for (int wv_ = gw; wv_ < 2 * 9 * 16; wv_ += NGW) { const int e = wv_ & 15, lb = wv_ >> 4; const float* md = WSP(float, WS_MODF) + (size_t)lb * 12288 + 6144; float a_ = 0.f;
                  for (int k = lane; k < D; k += 64) a_ += md[k] * rwp[(size_t)k * 16 + e];
                  a_ = wave_sum(a_, lane); if (lane == 0) CB[wv_] = a_; } }
            { const bool split = (NGW == 2048);
              for (int it = 0; ; ++it) {
                int rowbase, R;
                if (!split) { const int tile = gw + it * NGW; if (tile >= M / 8) break; rowbase = tile * 8; R = 8; }
                else if (it == 0) { rowbase = gw * 8; R = 8; }
                else if (it == 1 && F.wave < 2) { const int hh_ = F.bid * 2 + F.wave; rowbase = (2048 + (hh_ >> 1)) * 8 + (hh_ & 1) * 4; R = 4; }
                else break;
                const int b = rowbase < ML ? rowbase / T : 8;
                const f32x4* sc = (const f32x4*)(MODL + (size_t)b * 12288 + 2048); const f32x4* sh = (const f32x4*)(MODL + (size_t)b * 12288);
                f32x4 ga[8], gs[8];
#pragma unroll
                for (int j = 0; j < 8; ++j) { const int c4 = lane + 64 * j; ga[j] = ((const f32x4*)n1g_)[c4] * (sc[c4] + 1.0f); gs[j] = sh[c4]; }
#pragma unroll 2
                for (int r = 0; r < R; ++r) { const int row = rowbase + r;
                    const f32x4* xr = row < ML ? (const f32x4*)xin_ + (size_t)row * (D / 4) : (const f32x4*)cin_ + (size_t)(row - ML) * (D / 4);
                    f32x4 v[8]; float ss = 0.f;
#pragma unroll
                    for (int j = 0; j < 8; ++j) { v[j] = xr[lane + 64 * j]; ss += (v[j].x * v[j].x + v[j].y * v[j].y) + (v[j].z * v[j].z + v[j].w * v[j].w); }
                    const float ri = rsqrtf(wave_sum(ss, lane) * (1.f / D) + 1e-6f);
#pragma unroll
                    for (int j = 0; j < 8; ++j) { const int c4 = lane + 64 * j; const f32x4 hh = (v[j] * ri) * ga[j] + gs[j];
                        u32x2 w; w.x = pk2(hh.x, hh.y); w.y = pk2(hh.z, hh.w); ((u32x2*)(WSP(bf16, WS_H) + (size_t)row * D))[c4] = w; } }
              } }
        }
        if (l == 0) SEAM(pb + 0);

        if (PHEN(2) && IN(pb + 1)) REPL(2) {
            FRAME();
            const float* MODL = WSP(float, WS_MODF) + (size_t)l * 9 * 12288; (void)MODL;
            pg8::SchedWin S; S.H = (unsigned)WS_H; S.W = (unsigned)WS_WIN; S.Wv = (unsigned)(WS_WIN + (size_t)UW * D * 2); S.tstep = 256u * D * 2; S.n1 = (M / 256) * (UW / 256); S.G = F.G; S.c = F.bid; S.last = (l == 1);
            pg8::EpiWin E{WSP(bf16, WS_BIG), WSP(bf16, WS_VTN)};
            pg8::gemm_phase(F.lds, F.ws, D, S, E);
        }
        SEAM(pb + 1);

        if (PHEN(3) && IN(pb + 2)) REPL(3) {
            FRAME();
            const bf16* U = WSP(bf16, WS_BIG);
            LAS float* cmu = (LAS float*)F.lds; LAS float* ckk = cmu + 3488; LAS float* cqg = ckk + 1024; LAS float* ckg = cqg + 512;
            { const float* mu = INP(10) + (size_t)l * 3488; const float* kkw_ = INP(16) + l * 1024; const float* qng_ = INP(21) + l * 512; const float* kvg_ = INP(23) + l * 256;
              for (int i = F.tid; i < 3488; i += NTHR) cmu[i] = mu[i];
              for (int i = F.tid; i < 1024; i += NTHR) ckk[i] = kkw_[i];
              for (int i = F.tid; i < 512; i += NTHR) cqg[i] = qng_[i];
              for (int i = F.tid; i < 256; i += NTHR) ckg[i] = kvg_[i]; }
            __syncthreads();
            const int rpw = (M + NGW - 1) / NGW;
            for (int row = gw * rpw; row < min(M, (gw + 1) * rpw); ++row) {
                int t, tlen; if (row < ML) { t = row % T; tlen = T; } else { t = (row - ML) % TC; tlen = TC; }
                const bool hp = t > 0, hn = t < tlen - 1;
                const bf16* u0 = U + (size_t)row * UW + O_RW;
                const bf16* up = u0 - UW; const bf16* un = u0 + UW;
                unsigned W0[28], WP[28], WN[28], CQw[4], CKw[2];
#pragma unroll
                for (int p = 0; p < 28; ++p) { const int c = p < 24 ? (p >> 3) * 1024 + 128 * (p & 7) + 2 * lane : (p == 24 ? 3072 : (p == 25 ? 3200 : (p == 26 ? 3328 : 3456))) + 2 * lane;
                    const bool in = (p < 27) || (lane < 16);
                    W0[p] = in ? *(const unsigned*)(u0 + c) : 0u; WP[p] = (in && hp) ? *(const unsigned*)(up + c) : 0u; WN[p] = (in && hn) ? *(const unsigned*)(un + c) : 0u; }
#pragma unroll
                for (int j = 0; j < 4; ++j) CQw[j] = *(const unsigned*)(U + (size_t)row * UW + O_CQ + 128 * j + 2 * lane);
#pragma unroll
                for (int j = 0; j < 2; ++j) CKw[j] = *(const unsigned*)(U + (size_t)row * UW + O_CKV + 128 * j + 2 * lane);
                float xkr = bf2f(U[(size_t)row * UW + O_KR + (lane & 31)]);
                auto sh2 = [&](int p, int c, float& s0, float& s1) {
                    const float a0 = bflo(W0[p]), a1 = bfhi(W0[p]);
                    s0 = a0 + cmu[c] * (0.5f * (bflo(WP[p]) + bflo(WN[p])) - a0); s1 = a1 + cmu[c + 1] * (0.5f * (bfhi(WP[p]) + bfhi(WN[p])) - a1); };
#pragma unroll
                for (int j = 0; j < 8; ++j) { const int c = 128 * j + 2 * lane; float r0, r1, k0, k1, v0, v1;
                    sh2(j, c, r0, r1); sh2(8 + j, 1024 + c, k0, k1); sh2(16 + j, 2048 + c, v0, v1);
                    *(unsigned*)(WSP(bf16, WS_RS) + (size_t)row * 1024 + c) = pk2(r0, r1);
                    *(unsigned*)(WSP(bf16, WS_KS) + (size_t)row * 1024 + c) = pk2(k0, k1);
                    *(unsigned*)(WSP(bf16, WS_VS) + (size_t)row * 1024 + c) = pk2(v0, v1);
                    const float kk0 = k0 * ckk[c], kk1 = k1 * ckk[c + 1];
                    const float nn = half_sum(kk0 * kk0 + kk1 * kk1, lane); const float inv = __builtin_amdgcn_rsqf(fmaxf(nn, 1e-24f));
                    *(unsigned*)(WSP(bf16, WS_KK) + (size_t)row * 1024 + c) = pk2(kk0 * inv, kk1 * inv); }
                { float s0, s1; sh2(24, 3072 + 2 * lane, s0, s1); *(unsigned*)(WSP(bf16, WS_LA) + (size_t)row * 256 + 2 * lane) = pk2(1.f - 2.f * __builtin_amdgcn_rcpf(1.f + __expf(2.f * s0)), 1.f - 2.f * __builtin_amdgcn_rcpf(1.f + __expf(2.f * s1)));
                  sh2(25, 3200 + 2 * lane, s0, s1); *(unsigned*)(WSP(bf16, WS_LA) + (size_t)row * 256 + 128 + 2 * lane) = pk2(s0, s1); }
                { float s0, s1; sh2(26, 3328 + 2 * lane, s0, s1); *(unsigned*)(WSP(bf16, WS_LG) + (size_t)row * 256 + 2 * lane) = pk2(sigm(s0), sigm(s1));
                  unsigned w = 0u; if (lane < 16) { sh2(27, 3456 + 2 * lane, s0, s1); w = pk2(sigm(s0), sigm(s1)); }
                  *(unsigned*)(WSP(bf16, WS_LG) + (size_t)row * 256 + 128 + 2 * lane) = w; }
                { float x[8]; float ss = 0.f;
#pragma unroll
                  for (int j = 0; j < 4; ++j) { x[2 * j] = bflo(CQw[j]); x[2 * j + 1] = bfhi(CQw[j]); ss += x[2 * j] * x[2 * j] + x[2 * j + 1] * x[2 * j + 1]; }
                  const float rinv = rsqrtf(wave_sum(ss, lane) * (1.f / 512.f) + 1e-6f);
#pragma unroll
                  for (int j = 0; j < 4; ++j) { const int c = 128 * j + 2 * lane; *(unsigned*)(WSP(bf16, WS_CQN) + (size_t)row * 512 + c) = pk2(x[2 * j] * rinv * cqg[c], x[2 * j + 1] * rinv * cqg[c + 1]); } }
                { float x[4]; float ss = 0.f;
#pragma unroll
                  for (int j = 0; j < 2; ++j) { x[2 * j] = bflo(CKw[j]); x[2 * j + 1] = bfhi(CKw[j]); ss += x[2 * j] * x[2 * j] + x[2 * j + 1] * x[2 * j + 1]; }
                  const float rinv = rsqrtf(wave_sum(ss, lane) * (1.f / 256.f) + 1e-6f);
#pragma unroll
                  for (int j = 0; j < 2; ++j) { const int c = 128 * j + 2 * lane; *(unsigned*)(WSP(bf16, WS_CKVN) + (size_t)row * 256 + c) = pk2(x[2 * j] * rinv * ckg[c], x[2 * j + 1] * rinv * ckg[c + 1]); } }
                { const int d = lane & 31; float x = xkr; const float xo = shx(x, 8, lane);
                  if (row < ML) { const int hd = d >> 4, w = d & 15, i = w & 7; const float pos = (float)(hd ? (t & 63) : (t >> 6)); const float ang = pos * rope_inv(i); const float sn = __sinf(ang), cs = __cosf(ang);
                      x = (w < 8) ? (x * cs - xo * sn) : (xo * sn + x * cs); }
                  bf16* km = WSP(bf16, WS_KV) + (size_t)row * 1536 + 64 + d; const bf16 xb = (bf16)f2bf(x);
#pragma unroll
                  for (int h2 = 0; h2 < 8; ++h2) km[(2 * h2 + (lane >> 5)) * 96] = xb; }
            }
        }
        SEAM(pb + 2);

        if (PHEN(4) && IN(pb + 3)) REPL(4) {
            FRAME();
            const float* MODL = WSP(float, WS_MODF) + (size_t)l * 9 * 12288; (void)MODL;
            { pg8::SchedSmall S; S.a0 = (unsigned)WS_LA; S.b0 = (unsigned)WS_WA; S.a1 = (unsigned)WS_LG; S.b1 = (unsigned)WS_WG; S.a2 = (unsigned)WS_CKVN; S.b2 = (unsigned)WS_WUKV;
              S.a3 = (unsigned)(WS_WUKV + (size_t)1024 * 256 * 2); S.b3 = (unsigned)WS_CKVN; S.G = F.G; S.c = F.bid;
              pg8::EpiSmall E{WSP(_Float16, WS_DEC), WSP(bf16, WS_AA), INP(11) + l * 2048, INP(13) + l * 2048, WSP(bf16, WS_G), WSP(bf16, WS_KV), WSP(bf16, WS_VTM)};
              pg8::gemm_phase(F.lds, F.ws, 256, S, E); }
            { pg8::SchedDense S; S.init(WS_CQN, WS_WUQ, M, 1536, 512, F.G, F.bid);
              pg8::EpiStoreBf16 E{WSP(bf16, WS_Q), 1536, 0};
              pg8::gemm_phase(F.lds, F.ws, 512, S, E); }
        }
        SEAM(pb + 3);

        if (PHEN(5) && IN(pb + 4)) REPL(5) {
            FRAME();
            const float* MODL = WSP(float, WS_MODF) + (size_t)l * 9 * 12288; (void)MODL;
            const bf16* U = WSP(bf16, WS_BIG);
            if (MIXM & 1) for (int ch = F.bid; ch < 256; ch += F.G) {
                scan_chain(F.lds, F.tid, l, ch, WSP(bf16, WS_RS), WSP(bf16, WS_KS), WSP(bf16, WS_VS), WSP(bf16, WS_KK), WSP(_Float16, WS_DEC), WSP(bf16, WS_AA), INP(17) + l * 1024, WSP(bf16, WS_YS));
                __syncthreads();
            }
            __syncthreads();
            {
                const bf16* U = WSP(bf16, WS_BIG);
                const float LOG2E = 1.4426950408889634f;
                const int xcd = F.bid & 7, slot = F.bid >> 3; const bool deal = (F.G == 256);
                if (MIXM & 4) for (int i = 0; ; ++i) {
                    int un; if (deal) { if (i >= 4) break; un = (i * 32 + xcd * 4 + (slot >> 3)) * 8 + (slot & 7); } else { un = F.bid + i * F.G; if (un >= 1024) break; }
                    const int qb = un & 7, h = (un >> 3) & 15, b = un >> 7; const int q0 = b * T + qb * 256;
                    attn_unit<96, 1>(F.lds, F.tid, WSP(bf16, WS_Q) + (size_t)q0 * 1536 + h * 96, 1536, 0.10206207261596577f * LOG2E, qb * 256,
                                     WSP(bf16, WS_KV) + h * 96, 1536, WSP(bf16, WS_VTM) + (size_t)(h * 64) * M, M, 32, b * T, 4, ML + b * TC,
                                     WSP(bf16, WS_YNA) + (size_t)q0 * 3072 + 2048 + h * 64, nullptr, 0, 0);
                }
                if (MIXM & 2) for (int i = 0; ; ++i) {
                    int un; if (deal) { if (i >= 4) break; un = (i * 32 + xcd * 4 + (slot >> 3)) * 8 + (slot & 7); } else { un = F.bid + i * F.G; if (un >= 1024) break; }
                    const int ig = un & 7, h = (un >> 3) & 15, b = un >> 7; const int i0 = 4 * ig, q0 = b * T + i0 * 64;
                    int rlo = i0 - 4; rlo = rlo < 0 ? 0 : (rlo > 24 ? 24 : rlo); int rhi = i0 + 3 - 4; rhi = (rhi < 0 ? 0 : (rhi > 24 ? 24 : rhi)) + 8;
                    attn_unit<64, 2>(F.lds, F.tid, U + (size_t)q0 * UW + O_NAQ + h * 64, UW, 0.125f * LOG2E, 0,
                                     U + O_NAK + h * 64, UW, WSP(bf16, WS_VTN) + (size_t)(h * 64) * M, M, rhi - rlo, b * T + rlo * 64, 4, ML + b * TC,
                                     WSP(bf16, WS_YNA) + (size_t)q0 * 3072 + h * 64, INP(9) + (size_t)(l * 16 + h) * 465, i0, rlo);
                }
                if ((MIXM & 8) && l == 0) {
                    for (int un = F.bid; un < 128; un += F.G) { const int h = un & 15, b = un >> 4; const int q0 = ML + b * TC;
                        attn_unit<64, 0>(F.lds, F.tid, U + (size_t)q0 * UW + O_NAQ + h * 64, UW, 0.125f * LOG2E, 0,
                                         U + O_NAK + h * 64, UW, WSP(bf16, WS_VTN) + (size_t)(h * 64) * M, M, 0, 0, 4, q0,
                                         WSP(bf16, WS_YNA) + (size_t)q0 * 3072 + h * 64, nullptr, 0, 0); }
                    for (int un = (F.bid + F.G - 128 % F.G) % F.G; un < 128; un += F.G) { const int h = un & 15, b = un >> 4; const int q0 = ML + b * TC;
                        attn_unit<96, 0>(F.lds, F.tid, WSP(bf16, WS_Q) + (size_t)q0 * 1536 + h * 96, 1536, 0.10206207261596577f * LOG2E, 0,
                                         WSP(bf16, WS_KV) + h * 96, 1536, WSP(bf16, WS_VTM) + (size_t)(h * 64) * M, M, 0, 0, 4, q0,
                                         WSP(bf16, WS_YNA) + (size_t)q0 * 3072 + 2048 + h * 64, nullptr, 0, 0); }
                }
            }
        }
        SEAM(pb + 4);

        if (PHEN(6) && IN(pb + 5)) REPL(6) {
            FRAME();
            LAS float* crk = (LAS float*)F.lds; LAS float* cgw = crk + 1024; LAS float* cgb = cgw + 1024;
            { const float* rk_ = INP(18) + l * 1024; const float* gnw_ = INP(19) + l * 1024; const float* gnb_ = INP(20) + l * 1024;
              for (int i = F.tid; i < 1024; i += NTHR) { crk[i] = rk_[i]; cgw[i] = gnw_[i]; cgb[i] = gnb_[i]; } }
            __syncthreads();
            for (int row = gw; row < Mrows; row += NGW) {
                unsigned ya[8], yb[8], rw[8], kw[8], vw[8], gq[8];
#pragma unroll
                for (int j = 0; j < 8; ++j) { const size_t o = (size_t)row * 1024 + 128 * j + 2 * lane;
                    ya[j] = *(const unsigned*)(WSP(bf16, WS_YS) + o); yb[j] = *(const unsigned*)(WSP(bf16, WS_YS) + (size_t)M * 1024 + o);
                    rw[j] = *(const unsigned*)(WSP(bf16, WS_RS) + o); kw[j] = *(const unsigned*)(WSP(bf16, WS_KS) + o); vw[j] = *(const unsigned*)(WSP(bf16, WS_VS) + o); gq[j] = *(const unsigned*)(WSP(bf16, WS_G) + o); }
#pragma unroll
                for (int j = 0; j < 8; ++j) { const int c = 128 * j + 2 * lane;
                    const float y0 = bflo(ya[j]) + bflo(yb[j]), y1 = bfhi(ya[j]) + bfhi(yb[j]);
                    const float mean = half_sum(y0 + y1, lane) * (1.f / 64.f); const float d0 = y0 - mean, d1 = y1 - mean;
                    const float var = half_sum(d0 * d0 + d1 * d1, lane) * (1.f / 64.f); const float rs = rsqrtf(var + 64e-5f);
                    const float bd = half_sum(bflo(rw[j]) * bflo(kw[j]) * crk[c] + bfhi(rw[j]) * bfhi(kw[j]) * crk[c + 1], lane);
                    const float o0 = (d0 * rs * cgw[c] + cgb[c] + bd * bflo(vw[j])) * bflo(gq[j]), o1 = (d1 * rs * cgw[c + 1] + cgb[c + 1] + bd * bfhi(vw[j])) * bfhi(gq[j]);
                    *(unsigned*)(WSP(bf16, WS_YNA) + (size_t)row * 3072 + 1024 + c) = pk2(o0, o1); }
            }
        }
        SEAM(pb + 5);

        if (PHEN(7) && IN(pb + 6)) REPL(7) {
            FRAME();
            pg8::SchedDense S; S.init(WS_YNA, WS_WB, Mrows, D, 3072, F.G, F.bid);
            pg8::EpiBranch E{WSP(bf16, WS_MB), WSP(bf16, WS_BIG)};
            pg8::gemm_phase(F.lds, F.ws, 3072, S, E);
            if (l == 0 && F.G == 256 && F.bid >= 64) convert_weights(F, 1, 1 | 32, (F.bid - 64) * NWAVES + F.wave, 192 * NWAVES, (F.bid - 64) * NTHR + F.tid, 192 * NTHR);
        }
        SEAM(pb + 6);

        if (PHEN(8) && IN(pb + 7)) REPL(8) {
            FRAME();
            const float* MODL = WSP(float, WS_MODF) + (size_t)l * 9 * 12288; (void)MODL;
            pg8::SchedDense S; S.init(WS_MB, WS_WO, Mrows, D, D, F.G, F.bid);
            const float* bl_ = (l == 0) ? INP(0) : (const float*)WSP(float, WS_XR); const float* bc_ = (l == 0) ? INP(2) : (const float*)(WSP(float, WS_XR) + (size_t)ML * D);
            pg8::EpiResidual E{WSP(float, WS_XR), MODL + 4096, bl_, bc_};
            pg8::gemm_phase(F.lds, F.ws, D, S, E);
            if (l == 0 && F.G == 256 && F.bid >= 64) convert_weights(F, 1, 2 | 16, (F.bid - 64) * NWAVES + F.wave, 192 * NWAVES, (F.bid - 64) * NTHR + F.tid, 192 * NTHR);
        }
        SEAM(pb + 7);

        if (PHEN(9) && IN(pb + 8)) REPL(9) {
            FRAME();
            const float* MODL = WSP(float, WS_MODF) + (size_t)l * 9 * 12288; (void)MODL;
            const float* gp = INP(7) + l * D; const float* rbias = INP(28);
            int* TOKE = WSP(int, WS_ROUTE); int* TOKP = TOKE + 2 * M; float* TOKW = (float*)(TOKP + 2 * M);
            LAS float* lsc = (LAS float*)(F.lds + F.wave * 2048);
            const int rr = lane & 15, kg = lane >> 4;
            const bool split = (NGW == 2048) && (Mrows == M);
            for (int it = 0; ; ++it) {
                int rowbase, R;
                if (!split) { const int tile = gw + it * NGW; if (tile >= Mrows / 8) break; rowbase = tile * 8; R = 8; }
                else if (it == 0) { rowbase = gw * 8; R = 8; }
                else if (it == 1 && F.wave < 2) { const int hh_ = F.bid * 2 + F.wave; rowbase = (2048 + (hh_ >> 1)) * 8 + (hh_ & 1) * 4; R = 4; }
                else break;
                const int r8 = lane & (R - 1);
                const int b = rowbase < ML ? rowbase / T : 8;
                const f32x4* sc = (const f32x4*)(MODL + (size_t)b * 12288 + 8192); const f32x4* sh = (const f32x4*)(MODL + (size_t)b * 12288 + 6144);
                f32x4 ga[8], gs[8];
#pragma unroll
                for (int j = 0; j < 8; ++j) { const int c4 = lane + 64 * j; ga[j] = ((const f32x4*)gp)[c4] * (sc[c4] + 1.0f); gs[j] = sh[c4]; }
#pragma unroll 2
                for (int r = 0; r < R; ++r) { const f32x4* xr = WSP(f32x4, WS_XR) + (size_t)(rowbase + r) * (D / 4); f32x4 v[8]; float ss = 0.f;
#pragma unroll
                    for (int j = 0; j < 8; ++j) { v[j] = xr[lane + 64 * j]; ss += (v[j].x * v[j].x + v[j].y * v[j].y) + (v[j].z * v[j].z + v[j].w * v[j].w); }
                    const float ri = rsqrtf(wave_sum(ss, lane) * (1.f / D) + 1e-6f);
                    if (lane == 0) lsc[256 + r] = ri;
#pragma unroll
                    for (int j = 0; j < 8; ++j) { const int c4 = lane + 64 * j; const f32x4 hh = (v[j] * ri) * ga[j] + gs[j];
                        u32x2 w; w.x = pk2(hh.x, hh.y); w.y = pk2(hh.z, hh.w); ((u32x2*)(WSP(bf16, WS_H) + (size_t)(rowbase + r) * D))[c4] = w; } }
                const float* xrow = WSP(float, WS_XR) + (size_t)(rowbase + r8) * D + 8 * kg;
                const bf16* wh = WSP(bf16, WS_WRB) + ((size_t)(l * 9 + b) * 2 * 16 + rr) * D + 8 * kg; const bf16* wl = wh + 16 * D;
                f32x4 acc = (f32x4){0.f, 0.f, 0.f, 0.f};
#pragma unroll 8
                for (int st = 0; st < 64; ++st) { const int k0 = 32 * st;
                    const f32x4 x0 = *(const f32x4*)(xrow + k0), x1 = *(const f32x4*)(xrow + k0 + 4);
                    u32x4 hi; hi.x = pk2(x0.x, x0.y); hi.y = pk2(x0.z, x0.w); hi.z = pk2(x1.x, x1.y); hi.w = pk2(x1.z, x1.w);
                    u32x4 lo; lo.x = pk2(x0.x - bflo(hi.x), x0.y - bfhi(hi.x)); lo.y = pk2(x0.z - bflo(hi.y), x0.w - bfhi(hi.y)); lo.z = pk2(x1.x - bflo(hi.z), x1.y - bfhi(hi.z)); lo.w = pk2(x1.z - bflo(hi.w), x1.w - bfhi(hi.w));
                    const bf16x8 bh = *(const bf16x8*)(wh + k0), bl = *(const bf16x8*)(wl + k0);
                    acc = __builtin_amdgcn_mfma_f32_16x16x32_bf16(__builtin_bit_cast(bf16x8, hi), bh, acc, 0, 0, 0);
                    acc = __builtin_amdgcn_mfma_f32_16x16x32_bf16(__builtin_bit_cast(bf16x8, lo), bh, acc, 0, 0, 0);
                    acc = __builtin_amdgcn_mfma_f32_16x16x32_bf16(__builtin_bit_cast(bf16x8, hi), bl, acc, 0, 0, 0); }
                LDS_WAIT();
                { const float cb = WSP(float, WS_CB)[(l * 9 + b) * 16 + rr];
                  if (kg < 2) {
#pragma unroll
                      for (int i = 0; i < 4; ++i) lsc[(4 * kg + i) * 16 + rr] = acc[i] * lsc[256 + 4 * kg + i] + cb; } }
                LDS_WAIT();
                if (lane < R) { const int row = rowbase + lane;
                    float scs[16], sel[16];
#pragma unroll
                    for (int e4 = 0; e4 < 4; ++e4) { const f32x4 q4 = *(const LAS f32x4*)(lsc + lane * 16 + 4 * e4);
#pragma unroll
                        for (int i = 0; i < 4; ++i) { scs[4 * e4 + i] = sigm(q4[i]); sel[4 * e4 + i] = scs[4 * e4 + i] + rbias[4 * e4 + i]; } }
                    int bg = 0; float bgs = -1e30f;
#pragma unroll
                    for (int g4 = 0; g4 < 4; ++g4) { float m1 = -1e30f, m2 = -1e30f;
#pragma unroll
                        for (int i = 0; i < 4; ++i) { const float s_ = sel[4 * g4 + i]; if (s_ > m1) { m2 = m1; m1 = s_; } else if (s_ > m2) m2 = s_; }
                        const float gs = m1 + m2; if (gs > bgs) { bgs = gs; bg = g4; } }
                    int e1 = 0, e2 = 0; float s1 = -1e30f, s2 = -1e30f, c1 = 0.f, c2 = 0.f;
#pragma unroll
                    for (int g4 = 0; g4 < 4; ++g4)
#pragma unroll
                        for (int i = 0; i < 4; ++i) { const int e = 4 * g4 + i; const float s_ = sel[e], cc = scs[e];
                            if (g4 == bg) { if (s_ > s1) { s2 = s1; e2 = e1; c2 = c1; s1 = s_; e1 = e; c1 = cc; } else if (s_ > s2) { s2 = s_; e2 = e; c2 = cc; } } }
                    const unsigned p1 = atomicAdd(F.ctl + CW_CNT + l * 64 + e1, 1u), p2 = atomicAdd(F.ctl + CW_CNT + l * 64 + e2, 1u);
                    TOKE[2 * row] = e1; TOKE[2 * row + 1] = e2; TOKP[2 * row] = (int)p1; TOKP[2 * row + 1] = (int)p2;
                    { int* LIST = (int*)(F.ws + WS_ROUTE + 0xC0000); LIST[(size_t)e1 * M + p1] = row; LIST[(size_t)e2 * M + p2] = row; }
                    const float inv = __builtin_amdgcn_rcpf(c1 + c2); TOKW[2 * row] = c1 * inv; TOKW[2 * row + 1] = c2 * inv; }
                LDS_WAIT();
            }
        }
        SEAM(pb + 8);

        if (PHEN(10) && IN(pb + 9)) REPL(10) {
            FRAME();
            const float* MODL = WSP(float, WS_MODF) + (size_t)l * 9 * 12288; (void)MODL;
            int* TOKE = WSP(int, WS_ROUTE); int* TOKP = TOKE + 2 * M; int* DEST = TOKP + 4 * M; int* TILE_E = DEST + 2 * M;
            unsigned cnt = 0u; if (lane < 16) cnt = __hip_atomic_load(F.ctl + CW_CNT + l * 64 + lane, RLX_AGENT);
            const unsigned pad = (cnt + 255u) & ~255u;
            unsigned incl = pad;
#pragma unroll
            for (int o = 1; o < 16; o <<= 1) { const unsigned t = shl_u(incl, lane - o); if (lane >= o) incl += t; }
            const unsigned excl = incl - pad;
            if (F.bid == 0 && F.wave == 0) {
                const unsigned total = shl_u(incl, 15);
                for (int tl = lane; tl < MAXT; tl += 64) { int e = 0, p0 = 0, cn = 0;
#pragma unroll
                    for (int q = 0; q < 16; ++q) { const unsigned st = shl_u(excl, q), en = shl_u(incl, q), cq = shl_u(cnt, q); if ((unsigned)tl * 256u >= st && (unsigned)tl * 256u < en) { e = q; p0 = (int)((unsigned)tl * 256u - st); cn = (int)cq; } }
                    TILE_E[tl] = e; TILE_E[256 + tl] = p0; TILE_E[512 + tl] = cn; }
                if (lane == 0) TILE_E[MAXT] = (int)(total >> 8);
            }
            for (int r0 = gw * 32; r0 < Mrows; r0 += NGW * 32) {
                const int idx = 2 * r0 + lane; const int e = TOKE[idx], p = TOKP[idx];
                DEST[idx] = (int)shl_u(excl, e) + p; }
        }
        SEAM(pb + 9);

        if (PHEN(11) && IN(pb + 10)) REPL(11) {
            FRAME();
            const float* MODL = WSP(float, WS_MODF) + (size_t)l * 9 * 12288; (void)MODL;
            const int* TILE_E = WSP(int, WS_ROUTE) + 8 * M;
            pg8::SchedMoeG S; S.A = (unsigned)WS_H; S.B = (unsigned)WS_GU; S.K2 = (unsigned)D * 2; S.btstep = 256u * D * 2; S.estep = 2048u * D * 2;
            S.tile_e = TILE_E; S.tile_p0 = TILE_E + 256; S.tile_cn = TILE_E + 512; S.list = (const int*)(F.ws + WS_ROUTE + 0xC0000); S.ntiles = TILE_E[MAXT]; S.nN = 8; S.G = F.G; S.c = F.bid;
            pg8::EpiSwiglu E{WSP(bf16, WS_ACT)};
            pg8::gemm_phase(F.lds, F.ws, D, S, E);
        }
        SEAM(pb + 10);

        if (PHEN(12) && IN(pb + 11)) REPL(12) {
            FRAME();
            const float* MODL = WSP(float, WS_MODF) + (size_t)l * 9 * 12288; (void)MODL;
            const int* TILE_E = WSP(int, WS_ROUTE) + 8 * M;
            pg8::SchedMoe S; S.A = (unsigned)WS_ACT; S.B = (unsigned)(l == 0 ? WS_DN : WS_DN1); S.atstep = 256u * FE * 2; S.btstep = 256u * FE * 2; S.estep = (unsigned)D * FE * 2;
            S.tile_e = TILE_E; S.ntiles = TILE_E[MAXT]; S.nN = 8; S.G = F.G; S.c = F.bid;
            pg8::EpiStoreBf16 E{WSP(bf16, WS_OUTB), D, 0};
            pg8::gemm_phase(F.lds, F.ws, FE, S, E);
        }
        SEAM(pb + 11);

        if (PHEN(13) && IN(pb + 12)) REPL(13) {
            FRAME();
            const float* MODL = WSP(float, WS_MODF) + (size_t)l * 9 * 12288; (void)MODL;
            const int* DEST = WSP(int, WS_ROUTE) + 6 * M; const float* TOKW = (const float*)(WSP(int, WS_ROUTE) + 4 * M);
            const float* n1g1_ = INP(6) + D; const f32x4* fng_ = (const f32x4*)INP(31);
            const float* MOD1 = WSP(float, WS_MODF) + (size_t)9 * 12288;
            int nd0 = 0, nd1 = 0; float nw0 = 0.f, nw1 = 0.f;
            if (gw < Mrows) { nd0 = DEST[2 * gw]; nd1 = DEST[2 * gw + 1]; nw0 = TOKW[2 * gw]; nw1 = TOKW[2 * gw + 1]; }
#pragma unroll 1
            for (int row = gw; row < Mrows; row += NGW) {
                const int b = row < ML ? row / T : 8;
                const int d0 = nd0, d1 = nd1; const float w0 = nw0, w1 = nw1;
                f32x4* xr = WSP(f32x4, WS_XR) + (size_t)row * (D / 4);
                const u32x2* o0 = (const u32x2*)(WSP(bf16, WS_OUTB) + (size_t)d0 * D); const u32x2* o1 = (const u32x2*)(WSP(bf16, WS_OUTB) + (size_t)d1 * D);
                const f32x4* g2 = (const f32x4*)(MODL + (size_t)b * 12288 + 10240);
                f32x4 v[8]; float ss = 0.f;
                { u32x2 oa[8], oc[8]; f32x4 xv[8], gv2[8];
#pragma unroll
                  for (int j = 0; j < 8; ++j) { const int c4 = lane + 64 * j; oa[j] = o0[c4]; oc[j] = o1[c4]; xv[j] = xr[c4]; gv2[j] = g2[c4]; }
                  { const int nr = row + NGW; if (nr < Mrows) { nd0 = DEST[2 * nr]; nd1 = DEST[2 * nr + 1]; nw0 = TOKW[2 * nr]; nw1 = TOKW[2 * nr + 1]; } }
#pragma unroll
                  for (int j = 0; j < 8; ++j) { const u32x2 a_ = oa[j], c_ = oc[j];
                      f32x4 f; f.x = w0 * bflo(a_.x) + w1 * bflo(c_.x); f.y = w0 * bfhi(a_.x) + w1 * bfhi(c_.x); f.z = w0 * bflo(a_.y) + w1 * bflo(c_.y); f.w = w0 * bfhi(a_.y) + w1 * bfhi(c_.y);
                      v[j] = xv[j] + gv2[j] * f; ss += (v[j].x * v[j].x + v[j].y * v[j].y) + (v[j].z * v[j].z + v[j].w * v[j].w); } }
                asm volatile("" ::: "memory");
                const float rinv = rsqrtf(wave_sum(ss, lane) * (1.f / D) + 1e-6f);
                if (l == 0) {
                    f32x4 ng[8], nsc[8], nsh[8];
#pragma unroll
                    for (int j = 0; j < 8; ++j) { const int c4 = lane + 64 * j; ng[j] = ((const f32x4*)n1g1_)[c4]; nsc[j] = ((const f32x4*)(MOD1 + (size_t)b * 12288 + 2048))[c4]; nsh[j] = ((const f32x4*)(MOD1 + (size_t)b * 12288))[c4]; }
#pragma unroll
                    for (int j = 0; j < 8; ++j) { const int c4 = lane + 64 * j; xr[c4] = v[j];
                        const f32x4 hh = (v[j] * rinv) * ng[j] * (nsc[j] + 1.0f) + nsh[j];
                        u32x2 w; w.x = pk2(hh.x, hh.y); w.y = pk2(hh.z, hh.w); ((u32x2*)(WSP(bf16, WS_H) + (size_t)row * D))[c4] = w; }
                } else {
                    f32x4 ng[8];
#pragma unroll
                    for (int j = 0; j < 8; ++j) ng[j] = fng_[lane + 64 * j];
#pragma unroll
                    for (int j = 0; j < 8; ++j) { const int c4 = lane + 64 * j; ((f32x4*)(F.out + (size_t)row * D))[c4] = (v[j] * rinv) * ng[j]; }
                }
            }
            if (l == 0) { __syncthreads(); convert_weights(F, 1, F.G == 256 ? (4 | 8) : 63, F.bid * NWAVES + F.wave, F.G * NWAVES, F.bid * NTHR + F.tid, F.G * NTHR); }
        }
        if (l == 0) SEAM(pb + 12);
    }
#undef IN
#undef SEAM
}

typedef void (*kern_t)(Args);
template <unsigned PM> static bool prep_kernel() {
    if (hipFuncSetAttribute((const void*)fwd_kernel<PM>, hipFuncAttributeMaxDynamicSharedMemorySize, LDS_BYTES) != hipSuccess) { fprintf(stderr, "kernel_launch: hipFuncSetAttribute failed\n"); return false; }
    return true;
}
extern "C" void kernel_launch(void* const* d_in, const int* in_sizes, int n_in, void* d_out, int out_size, void* d_ws, size_t ws_size, hipStream_t stream) {
    static int grid = 0;
#if MK_N_LAUNCHES == 1
    static kern_t kern[1] = { fwd_kernel<0x3FFFu> };
#else
    static kern_t kern[14] = { fwd_kernel<1u << 0>, fwd_kernel<1u << 1>, fwd_kernel<1u << 2>, fwd_kernel<1u << 3>, fwd_kernel<1u << 4>, fwd_kernel<1u << 5>, fwd_kernel<1u << 6>, fwd_kernel<1u << 7>,
                               fwd_kernel<1u << 8>, fwd_kernel<1u << 9>, fwd_kernel<1u << 10>, fwd_kernel<1u << 11>, fwd_kernel<1u << 12>, fwd_kernel<1u << 13> };
#endif
    if (grid == 0) {
        if (n_in != 32 || out_size != ML * D || ws_size < WS_END) { fprintf(stderr, "kernel_launch: unexpected problem: n_in %d out %d ws %zu\n", n_in, out_size, ws_size); grid = -1; return; }
        int dev = 0, cus = 0;
        if (hipGetDevice(&dev) != hipSuccess || hipDeviceGetAttribute(&cus, hipDeviceAttributeMultiprocessorCount, dev) != hipSuccess) { grid = -1; return; }
        bool ok = true;
#if MK_N_LAUNCHES == 1
        ok = prep_kernel<0x3FFFu>();
        int per_cu = 0;
        if (hipOccupancyMaxActiveBlocksPerMultiprocessor(&per_cu, (const void*)fwd_kernel<0x3FFFu>, NTHR, LDS_BYTES) != hipSuccess || per_cu < 1) { fprintf(stderr, "kernel_launch: occupancy query says %d\n", per_cu); }
#else
        ok = prep_kernel<1u << 0>() && prep_kernel<1u << 1>() && prep_kernel<1u << 2>() && prep_kernel<1u << 3>() && prep_kernel<1u << 4>() && prep_kernel<1u << 5>() && prep_kernel<1u << 6>() && prep_kernel<1u << 7>()
          && prep_kernel<1u << 8>() && prep_kernel<1u << 9>() && prep_kernel<1u << 10>() && prep_kernel<1u << 11>() && prep_kernel<1u << 12>() && prep_kernel<1u << 13>();
#endif
        (void)hipGetLastError();
        if (!ok) { grid = -1; return; }
        grid = cus;
    }
    if (grid < 0) return;
    if (hipMemsetAsync((char*)d_ws + WS_CTL, 0, CTL_ZERO_BYTES, stream) != hipSuccess) return;
    Args a{};
    for (int i = 0; i < 32; ++i) a.in[i] = (const float*)d_in[i];
    a.out = (float*)d_out; a.ws = (unsigned char*)d_ws;
#if MK_N_LAUNCHES == 1
    a.ph_lo = 0; a.ph_hi = N_PHASES;
    hipLaunchKernelGGL(kern[0], dim3(grid), dim3(NTHR), LDS_BYTES, stream, a);
#else
    for (int p = 0; p < N_PHASES; ++p) {
        if (p == 1 + PH_PER_LAYER) continue;
        a.ph_lo = p; a.ph_hi = p + 1;
        const int j = p == 0 ? 0 : 1 + (p - 1) % PH_PER_LAYER;
        hipLaunchKernelGGL(kern[j], dim3(grid), dim3(NTHR), LDS_BYTES, stream, a);
    }
#endif
}
```

```cpp
#include <hip/hip_runtime.h>
#include <cstdio>
#include <cstdint>

#ifndef MK_N_LAUNCHES
#define MK_N_LAUNCHES 1
#endif

#ifndef REPMASK
#define REPMASK 0u
#endif
#define REPL(j) for (int rep_ = 0; rep_ < 1 + (int)(((REPMASK) >> (j)) & 1u); ++rep_, (REPMASK) ? __syncthreads() : (void)0)
#ifndef MIXM
#define MIXM 15
#endif
#ifndef SUBM
#define SUBM 15
#endif
#define PHEN(j) (((PM) >> (j)) & 1u)
#define LAS __attribute__((address_space(3)))
#define GAS __attribute__((address_space(1)))
typedef unsigned short bf16;
typedef short bf16x8 __attribute__((ext_vector_type(8)));
typedef float f32x4 __attribute__((ext_vector_type(4)));
typedef float f32x2 __attribute__((ext_vector_type(2)));
typedef unsigned u32x4 __attribute__((ext_vector_type(4)));
typedef unsigned u32x2 __attribute__((ext_vector_type(2)));

constexpr int D = 2048, NB = 8, T = 2048, TC = 256, ML = NB * T, MC = NB * TC, M = ML + MC;
constexpr int INW = 13504;
constexpr int UW = 12544;
constexpr int INWP = 13568;
constexpr int O_NAQ = 0, O_NAK = 1024, O_RW = 2048, O_CQ = 5536, O_CKV = 6048, O_KR = 6304, O_GATE = 6336;
constexpr int NE = 16, FE = 1024, MAXT = 160;
constexpr int NWAVES = 8, NTHR = 512;
constexpr int PH_PER_LAYER = 13, N_PHASES = 1 + 2 * PH_PER_LAYER;

constexpr size_t MiB = 1u << 20;
constexpr size_t WS_CTL = 0, CTL_ZERO_BYTES = 1 * MiB;
constexpr size_t WS_MODF = 1 * MiB;
constexpr size_t WS_ROUTE = 2 * MiB;
constexpr size_t WS_WIN = 4 * MiB, WS_WB = 57 * MiB, WS_WO = 69 * MiB, WS_GU = 77 * MiB, WS_DN = 205 * MiB, WS_WUQ = 269 * MiB, WS_WUKV = 271 * MiB, WS_WA = 272 * MiB, WS_WG = 274 * MiB;
constexpr size_t WS_XR = 276 * MiB, WS_H = 420 * MiB, WS_BIG = 492 * MiB;
constexpr size_t WS_BUF = WS_BIG, WS_ACT = WS_BIG + 160 * MiB, WS_OUTB = WS_BIG + 240 * MiB;
constexpr size_t WS_RS = 969 * MiB, WS_KS = 1005 * MiB, WS_VS = 1041 * MiB, WS_KK = 1077 * MiB;
constexpr size_t WS_DEC = 1113 * MiB, WS_AA = 1257 * MiB, WS_G = 1329 * MiB, WS_YS = 1365 * MiB;
constexpr size_t WS_MRG = WS_DEC, WS_MB = WS_AA;
constexpr size_t WS_Q = 1509 * MiB, WS_KV = 1563 * MiB, WS_YNA = 1635 * MiB, WS_YRW = 1671 * MiB, WS_YMLA = 1707 * MiB;
constexpr size_t WS_LA = 1743 * MiB, WS_LG = 1752 * MiB, WS_CQN = 1761 * MiB, WS_CKVN = 1779 * MiB, WS_VTM = 1790 * MiB, WS_VTN = 1826 * MiB, WS_WRB = 1862 * MiB, WS_CB = 1865 * MiB, WS_DN1 = 1866 * MiB, WS_END = 1930 * MiB;
static_assert(WS_WIN + (size_t)INWP * D * 2 <= WS_WB && WS_BIG + (size_t)M * UW * 2 <= WS_RS && WS_OUTB + (size_t)MAXT * 256 * D * 2 <= WS_RS, "ws map");
constexpr int CW_TMO = 0, CW_CNT = 1024  , CW_BAR = 4096;

constexpr int RING_BYTES = 131072, MISC_OFF = RING_BYTES + 320, LDS_BYTES = 147456;

#define RLX_AGENT __ATOMIC_RELAXED, __HIP_MEMORY_SCOPE_AGENT
#define LDS_WAIT() asm volatile("s_waitcnt lgkmcnt(0)" ::: "memory")
#define VM_WAIT() asm volatile("s_waitcnt vmcnt(0)" ::: "memory")

typedef __bf16 bf16v2 __attribute__((ext_vector_type(2)));
__device__ __forceinline__ unsigned pk2(float lo, float hi) { return __builtin_bit_cast(unsigned, __builtin_convertvector(((f32x2){lo, hi}), bf16v2)); }
__device__ __forceinline__ unsigned f2bf(float f) { return pk2(f, 0.f) & 0xffffu; }
__device__ __forceinline__ float bflo(unsigned w) { return __builtin_bit_cast(float, w << 16); }
__device__ __forceinline__ float bfhi(unsigned w) { return __builtin_bit_cast(float, w & 0xffff0000u); }
__device__ __forceinline__ float bf2f(bf16 b) { return __builtin_bit_cast(float, ((unsigned)b) << 16); }
__device__ __forceinline__ float shx(float v, int o, int lane) { return __builtin_bit_cast(float, __builtin_amdgcn_ds_bpermute((lane ^ o) << 2, __builtin_bit_cast(int, v))); }
__device__ __forceinline__ unsigned shl_u(unsigned v, int src) { return (unsigned)__builtin_amdgcn_ds_bpermute(src << 2, (int)v); }
template <int CTRL> __device__ __forceinline__ float dpp_f(float v) { return __builtin_bit_cast(float, __builtin_amdgcn_update_dpp(0, __builtin_bit_cast(int, v), CTRL, 0xF, 0xF, true)); }
__device__ __forceinline__ float row_sum16(float v) { v += dpp_f<0xB1>(v); v += dpp_f<0x4E>(v); v += dpp_f<0x141>(v); v += dpp_f<0x140>(v); return v; }
__device__ __forceinline__ float wave_sum(float v, int lane) { v = row_sum16(v); v += shx(v, 16, lane); v += shx(v, 32, lane); return v; }
__device__ __forceinline__ float half_sum(float v, int lane) { v = row_sum16(v); v += shx(v, 16, lane); return v; }
__device__ __forceinline__ float sigm(float x) { return __builtin_amdgcn_rcpf(1.f + __expf(-x)); }
typedef _Float16 f16x2_t __attribute__((ext_vector_type(2)));
typedef float f32x2_t __attribute__((ext_vector_type(2)));
__device__ __forceinline__ unsigned pkh2(float a, float b) { return __builtin_bit_cast(unsigned, __builtin_convertvector((f32x2_t){a, b}, f16x2_t)); }
__device__ __forceinline__ float h2lo(unsigned w) { return (float)__builtin_bit_cast(f16x2_t, w).x; }
__device__ __forceinline__ float h2hi(unsigned w) { return (float)__builtin_bit_cast(f16x2_t, w).y; }

#define XB_TMO      128
#define XB_XCNT(j)  (256  + 64 * (j))
#define XB_XSUB(j)  (1280 + 64 * (j))
#define XB_XGEN(j)  (2304 + 64 * (j))
#define XB_TOP      3328
#define XB_TOPGEN   3392
#define XCD_BAR_WORDS 3456
#define XB_SPIN_CAP (1u << 22)
__device__ __forceinline__ unsigned xb_ld(unsigned* p)              { return __hip_atomic_load(p, __ATOMIC_RELAXED, __HIP_MEMORY_SCOPE_AGENT); }
__device__ __forceinline__ unsigned xb_add(unsigned* p, unsigned v) { return __hip_atomic_fetch_add(p, v, __ATOMIC_RELAXED, __HIP_MEMORY_SCOPE_AGENT); }
__device__ __forceinline__ unsigned xb_xcc_id() { return (unsigned)__builtin_amdgcn_s_getreg((3 << 11) | 20) & 0xFu; }
#define XB_SPIN(cond, bar) do { unsigned _sp = 0; while (cond) { __builtin_amdgcn_s_sleep(1); \
    if ((++_sp & 255u) == 0u) { if (xb_ld(&(bar)[XB_TMO])) break; if (_sp > XB_SPIN_CAP) { atomicAdd(&(bar)[XB_TMO], 1u); break; } } } } while (0)
struct XcdBarrier { unsigned* bar; unsigned x; volatile LAS unsigned* st; };
__device__ __forceinline__ XcdBarrier xcd_barrier_post(unsigned* bar, volatile LAS unsigned* st) {
    XcdBarrier b; b.bar = bar; b.x = xb_xcc_id(); b.st = st;
    if (threadIdx.x == 0) (void)xb_add(&bar[XB_XCNT(b.x)], 1u);
    return b;
}
__device__ __forceinline__ void xcd_barrier_complete(unsigned* bar, unsigned x, unsigned& nloc, unsigned& nx) {
    const unsigned G = gridDim.x * gridDim.y * gridDim.z;
    unsigned sum, cnt, mine, sp = 0u;
    for (;;) {
        sum = 0u; cnt = 0u; mine = 0u;
#pragma unroll
        for (unsigned j = 0; j < 16; ++j) { const unsigned c = xb_ld(&bar[XB_XCNT(j)]); sum += c; cnt += (c > 0u) ? 1u : 0u; mine = (j == x) ? c : mine; }
        if (sum == G) break;
        __builtin_amdgcn_s_sleep(1);
        if ((++sp & 255u) == 0u) { if (xb_ld(&bar[XB_TMO])) break; if (sp > XB_SPIN_CAP) { atomicAdd(&bar[XB_TMO], 1u); break; } }
    }
    nloc = mine > 0u ? mine : 1u; nx = cnt > 0u ? cnt : 1u;
}
__device__ __forceinline__ void xcd_barrier(const XcdBarrier& b) {
    asm volatile("s_waitcnt vmcnt(0)" ::: "memory");
    __syncthreads();
    if (threadIdx.x == 0) {
        unsigned* bar = b.bar;
        __builtin_amdgcn_s_waitcnt(0);
        unsigned nloc = b.st[0], nx = b.st[1];
        if (nloc == 0u) { xcd_barrier_complete(bar, b.x, nloc, nx); b.st[0] = nloc; b.st[1] = nx; }
        const unsigned old = xb_add(&bar[XB_XSUB(b.x)], 1u);
        const unsigned gen = old / nloc;
        if (old + 1u == (gen + 1u) * nloc) {
            __builtin_amdgcn_fence(__ATOMIC_RELEASE, "agent");
            asm volatile("s_waitcnt vmcnt(0)" ::: "memory");
            const unsigned og = xb_add(&bar[XB_TOP], 1u);
            const unsigned tg = og / nx;
            if (og + 1u == (tg + 1u) * nx) xb_add(&bar[XB_TOPGEN], 1u);
            else XB_SPIN(xb_ld(&bar[XB_TOPGEN]) == tg, bar);
            __builtin_amdgcn_fence(__ATOMIC_ACQUIRE, "agent");
            xb_add(&bar[XB_XGEN(b.x)], 1u);
            asm volatile("s_waitcnt vmcnt(0)" ::: "memory");
        } else {
            XB_SPIN(xb_ld(&bar[XB_XGEN(b.x)]) == gen, bar);
            __builtin_amdgcn_fence(__ATOMIC_ACQUIRE, "agent");
            asm volatile("s_waitcnt vmcnt(0)" ::: "memory");
        }
    }
    __syncthreads();
}

namespace pg8 {
constexpr int BM = 256, BK = 64, HALF = 128, HTB = HALF * BK * 2, STAGE_BYTES = 8 * HTB, NXCD = 8, WGM = 8;
__host__ __device__ __forceinline__ int lds_byte(int r, int c) { const int st = (r >> 4) * 2 + (c >> 5), rr = r & 15, cc = c & 31, ob = rr * 64 + cc * 2; return st * 1024 + (ob ^ (((ob >> 9) & 1) << 5)); }
__host__ __device__ __forceinline__ void stage_rc(int b, int& R, int& C) { const int st = b / 1024, sb = b % 1024, swz = sb ^ (((sb >> 9) & 1) << 5); R = (st >> 1) * 16 + swz / 64; C = (st & 1) * 32 + (swz % 64) / 2; }
__host__ __device__ __forceinline__ int perm32(int rho) { const int n = rho >> 4, i = rho & 15; return 8 * (i >> 2) + 4 * n + (i & 3); }
struct Unit { int pm, pn, z; };
__device__ __forceinline__ unsigned cvt_pk_bf16(float lo, float hi) { return pk2(lo, hi); }

__device__ __forceinline__ bool static_tile(long L, int nM, int nN, int& pm, int& pn) {
    const int nwg = nM * nN; if (L >= nwg) return false;
    int wgid = (int)L; { const int q = nwg / NXCD, r = nwg % NXCD, xcd = wgid % NXCD, off = wgid / NXCD; wgid = (xcd < r ? xcd * (q + 1) : r * (q + 1) + (xcd - r) * q) + off; }
    const int nig = WGM * nN, gid = wgid / nig, fm = gid * WGM, gsz = (nM - fm) < WGM ? (nM - fm) : WGM;
    pm = fm + ((wgid % nig) % gsz); pn = (wgid % nig) / gsz; return true;
}
struct SchedDense {
    static constexpr bool GATHER = false;
    unsigned A, B, tstep; int nM, nN, G, c;
    __device__ __forceinline__ void init(size_t A_, size_t B_, int M_, int N_, int K_, int G_, int c_) { A = (unsigned)A_; B = (unsigned)B_; tstep = (unsigned)BM * K_ * 2; nM = M_ / BM; nN = N_ / BM; G = G_; c = c_; }
    __device__ __forceinline__ bool next(int i, Unit& u) const { u.z = 0; return static_tile((long)i * G + c, nM, nN, u.pm, u.pn); }
    __device__ __forceinline__ unsigned Ap(const Unit& u) const { return A + (unsigned)u.pm * tstep; }
    __device__ __forceinline__ unsigned Bp(const Unit& u) const { return B + (unsigned)u.pn * tstep; }
};
struct SchedWin {
    static constexpr bool GATHER = false;
    unsigned H, W, Wv, tstep; int n1, G, c, last;
    __device__ __forceinline__ bool next(int i, Unit& u) const { long L = (long)i * G + c;
        if (!last) { if (L < n1) { u.z = 0; return static_tile(L, M / BM, UW / BM, u.pm, u.pn); } L -= n1; }
        else { constexpr int NLAT = (ML / BM) * (UW / BM), NCTX = (MC / BM) * 20;
            if (L < NLAT) { u.z = 0; return static_tile(L, ML / BM, UW / BM, u.pm, u.pn); } L -= NLAT;
            if (L < NCTX) { u.z = 0; const int idx = (int)L % 20; u.pm = ML / BM + (int)L / 20; u.pn = idx < 18 ? 4 + idx : 5 + idx; return true; } L -= NCTX; }
        u.z = 1; return static_tile(L, 1024 / BM, M / BM, u.pm, u.pn); }
    __device__ __forceinline__ unsigned Ap(const Unit& u) const { return H + (unsigned)u.z * (Wv - H) + (unsigned)u.pm * tstep; }
    __device__ __forceinline__ unsigned Bp(const Unit& u) const { return W + (unsigned)u.z * (H - W) + (unsigned)u.pn * tstep; }
};
struct EpiWin {
    static constexpr bool PERM = true, MID = false;
    bf16* Uo; bf16* VT;
    __device__ __forceinline__ void operator()(const f32x4 (&acc)[2][2][4][2], const Unit& u, int wr, int wc, int fr, int fq) const {
        const int row0 = u.pm * BM + wr * 64 + fr, col0 = u.pn * BM + wc * 32 + 8 * fq;
        bf16* O = Uo + (ptrdiff_t)u.z * (VT - Uo); const int ldc = UW + u.z * (M - UW);
#pragma unroll
        for (int ai = 0; ai < 2; ++ai)
#pragma unroll
            for (int m = 0; m < 4; ++m) { bf16* rowp = O + (size_t)(row0 + ai * HALF + m * 16) * ldc + col0;
#pragma unroll
                for (int bj = 0; bj < 2; ++bj) { const f32x4 v0 = acc[ai][bj][m][0], v1 = acc[ai][bj][m][1];
                    u32x4 w; w.x = cvt_pk_bf16(v0[0], v0[1]); w.y = cvt_pk_bf16(v0[2], v0[3]); w.z = cvt_pk_bf16(v1[0], v1[1]); w.w = cvt_pk_bf16(v1[2], v1[3]);
                    *(u32x4*)(rowp + bj * HALF) = w; } }
    }
};
struct SchedSmall {
    static constexpr bool GATHER = false;
    unsigned a0, a1, a2, a3, b0, b1, b2, b3; int G, c;
    __device__ __forceinline__ bool next(int i, Unit& u) const { long L = (long)i * G + c;
        if (L < 1152) { u.z = 0; return static_tile(L, 72, 16, u.pm, u.pn); } L -= 1152;
        if (L < 288) { u.z = 1; return static_tile(L, 72, 4, u.pm, u.pn); } L -= 288;
        if (L < 288) { u.z = 2; return static_tile(L, 72, 4, u.pm, u.pn); } L -= 288;
        u.z = 3; return static_tile(L, 4, 72, u.pm, u.pn); }
    __device__ __forceinline__ unsigned Ap(const Unit& u) const { return a0 + (unsigned)(u.z == 1) * (a1 - a0) + (unsigned)(u.z == 2) * (a2 - a0) + (unsigned)(u.z == 3) * (a3 - a0) + (unsigned)u.pm * (256u * 256 * 2); }
    __device__ __forceinline__ unsigned Bp(const Unit& u) const { return b0 + (unsigned)(u.z == 1) * (b1 - b0) + (unsigned)(u.z == 2) * (b2 - b0) + (unsigned)(u.z == 3) * (b3 - b0) + (unsigned)u.pn * (256u * 256 * 2); }
};
struct EpiSmall {
    static constexpr bool PERM = true, MID = false;
    _Float16* DEC; bf16* AA; const float* w0; const float* a0v; bf16* Gb; bf16* KM; bf16* VTM;
    __device__ __forceinline__ void operator()(const f32x4 (&acc)[2][2][4][2], const Unit& u, int wr, int wc, int fr, int fq) const {
        const int row0 = u.pm * BM + wr * 64 + fr, col0 = u.pn * BM + wc * 32 + 8 * fq;
        if (u.z == 0) {
            if (u.pn < 8) {
#pragma unroll
                for (int bj = 0; bj < 2; ++bj) { const int col = col0 + bj * HALF; const f32x4 b0_ = *(const f32x4*)(w0 + col), b1_ = *(const f32x4*)(w0 + col + 4);
#pragma unroll
                    for (int ai = 0; ai < 2; ++ai)
#pragma unroll
                        for (int m = 0; m < 4; ++m) { const size_t row = (size_t)(row0 + ai * HALF + m * 16); const f32x4 x0 = acc[ai][bj][m][0] + b0_, x1 = acc[ai][bj][m][1] + b1_; f32x4 o0, o1;
#pragma unroll
                            for (int j = 0; j < 4; ++j) { o0[j] = __expf(-0.6065306597126334f * sigm(x0[j]));
                                                          o1[j] = __expf(-0.6065306597126334f * sigm(x1[j])); }
                            u32x4 wq; wq.x = pkh2(o0[0], o0[1]); wq.y = pkh2(o0[2], o0[3]); wq.z = pkh2(o1[0], o1[1]); wq.w = pkh2(o1[2], o1[3]);
                            *(u32x4*)(DEC + row * 2048 + col) = wq; } }
            } else {
#pragma unroll
                for (int bj = 0; bj < 2; ++bj) { const int col = col0 + bj * HALF - 2048; const f32x4 b0_ = *(const f32x4*)(a0v + col), b1_ = *(const f32x4*)(a0v + col + 4);
#pragma unroll
                    for (int ai = 0; ai < 2; ++ai)
#pragma unroll
                        for (int m = 0; m < 4; ++m) { const size_t row = (size_t)(row0 + ai * HALF + m * 16); const f32x4 x0 = acc[ai][bj][m][0] + b0_, x1 = acc[ai][bj][m][1] + b1_;
                            u32x4 w; w.x = pk2(sigm(x0[0]), sigm(x0[1])); w.y = pk2(sigm(x0[2]), sigm(x0[3])); w.z = pk2(sigm(x1[0]), sigm(x1[1])); w.w = pk2(sigm(x1[2]), sigm(x1[3]));
                            *(u32x4*)(AA + row * 2048 + col) = w; } }
            }
        } else {
            bf16* O = Gb + (ptrdiff_t)(u.z == 2) * (KM - Gb) + (ptrdiff_t)(u.z == 3) * (VTM - Gb);
            const int ldc = 1024 + (u.z == 2) * 512 + (u.z == 3) * (M - 1024);
            const int rm = (u.z == 2);
            const int colr = rm ? (col0 >> 6) * 96 + (col0 & 63) : col0, bstep = rm ? 192 : HALF;
#pragma unroll
            for (int ai = 0; ai < 2; ++ai)
#pragma unroll
                for (int m = 0; m < 4; ++m) { bf16* rowp = O + (size_t)(row0 + ai * HALF + m * 16) * ldc + colr;
#pragma unroll
                    for (int bj = 0; bj < 2; ++bj) { const f32x4 v0 = acc[ai][bj][m][0], v1 = acc[ai][bj][m][1];
                        u32x4 w; w.x = cvt_pk_bf16(v0[0], v0[1]); w.y = cvt_pk_bf16(v0[2], v0[3]); w.z = cvt_pk_bf16(v1[0], v1[1]); w.w = cvt_pk_bf16(v1[2], v1[3]);
                        *(u32x4*)(rowp + bj * bstep) = w; } }
        }
    }
};
struct SchedBranch {
    static constexpr bool GATHER = false;
    unsigned A0, A1, A2, B, tstep, zstepB; int nM, nN, G, c;
    __device__ __forceinline__ bool next(int i, Unit& u) const { u.z = i % 3; return static_tile((long)(i / 3) * G + c, nM, nN, u.pm, u.pn); }
    __device__ __forceinline__ unsigned Ap(const Unit& u) const { return (u.z == 0 ? A0 : (u.z == 1 ? A1 : A2)) + (unsigned)u.pm * tstep; }
    __device__ __forceinline__ unsigned Bp(const Unit& u) const { return B + (unsigned)u.z * zstepB + (unsigned)u.pn * tstep; }
};
struct SchedMoe {
    static constexpr bool GATHER = false;
    unsigned A, B, atstep, btstep, estep; const int* tile_e; int ntiles, nN, G, c;
    __device__ __forceinline__ bool next(int i, Unit& u) const { if (!static_tile((long)i * G + c, ntiles, nN, u.pm, u.pn)) return false; u.z = tile_e[u.pm]; return true; }
    __device__ __forceinline__ unsigned Ap(const Unit& u) const { return A + (unsigned)u.pm * atstep; }
    __device__ __forceinline__ unsigned Bp(const Unit& u) const { return B + (unsigned)u.z * estep + (unsigned)u.pn * btstep; }
};

struct SchedMoeG {
    static constexpr bool GATHER = true;
    unsigned A, B, btstep, estep, K2; const int* tile_e; const int* tile_p0; const int* tile_cn; const int* list; int ntiles, nN, G, c;
    __device__ __forceinline__ bool next(int i, Unit& u) const { if (!static_tile((long)i * G + c, ntiles, nN, u.pm, u.pn)) return false; u.z = tile_e[u.pm]; return true; }
    __device__ __forceinline__ unsigned Ap(const Unit&) const { return A; }
    __device__ __forceinline__ unsigned Bp(const Unit& u) const { return B + (unsigned)u.z * estep + (unsigned)u.pn * btstep; }
    __device__ __forceinline__ void arows(const Unit& u, const int (&R)[2], const unsigned (&C2)[2], unsigned (&vo)[2][2]) const {
        const int p0 = tile_p0[u.pm], cn = tile_cn[u.pm]; const int* lp = list + (size_t)u.z * M + p0;
#pragma unroll
        for (int h = 0; h < 2; ++h)
#pragma unroll
            for (int i = 0; i < 2; ++i) { const int p = h * HALF + R[i]; int tok = 0; if (p0 + p < cn) tok = lp[p]; vo[h][i] = (unsigned)tok * K2 + C2[i]; }
    }
};

template <class Epi, class Sched>
__device__ __forceinline__ void gemm_phase(LAS unsigned char* lds, const unsigned char* wsbase, const int K_, const Sched& S, const Epi& E) {
    int tid = threadIdx.x; asm volatile("" : "+v"(tid));
    int K = K_; asm volatile("" : "+s"(K));
    const int wid = __builtin_amdgcn_readfirstlane(tid >> 6), lane = tid & 63, wr = wid >> 2, wc = wid & 3, fr = lane & 15, fq = lane >> 4;
    const int nt = K / BK;
    constexpr bool GA = Sched::GATHER;
    unsigned voffA[2], voffB[2], cv[2][2] = {{0u, 0u}, {0u, 0u}}, nv[2][2] = {{0u, 0u}, {0u, 0u}}; int RA[2]; unsigned CA2[2];
#pragma unroll
    for (int i = 0; i < 2; ++i) { int R, C; stage_rc(tid * 16 + i * 8192, R, C); const int Rb = Epi::PERM ? ((R & ~31) + perm32(R & 31)) : R; RA[i] = R; CA2[i] = (unsigned)C * 2u;
        voffA[i] = (unsigned)(R * K + C) * 2u; voffB[i] = (unsigned)(Rb * K + C) * 2u; }
    const unsigned kstep = (unsigned)(BK * 2);
    const unsigned hstep = (unsigned)HALF * K * 2;
    const unsigned ldsw = (unsigned)wid * 1024u;
    const int aoff = lds_byte(wr * 64 + fr, fq * 8), boff = lds_byte(wc * 32 + fr, fq * 8);
#define PG8_SA(b, h) (((b) * 2 + (h)) * HTB)
#define PG8_SB(b, h) ((4 + (b) * 2 + (h)) * HTB)
#define PG8_STAGE(bufoff, gbase, voff) do { _Pragma("unroll") for (int _i = 0; _i < 2; ++_i) \
        __builtin_amdgcn_global_load_lds((const unsigned*)(wsbase + (size_t)(unsigned)((gbase) + (voff)[_i])), (LAS unsigned*)(lds + (bufoff) + ldsw + _i * 8192), 16, 0, 0); } while (0)
#define PG8_STAGE_A(bufoff, gbase, h, V) do { _Pragma("unroll") for (int _i = 0; _i < 2; ++_i) { const unsigned _o = GA ? (gbase) + (V)[h][_i] : (gbase) + (unsigned)(h) * hstep + voffA[_i]; \
        __builtin_amdgcn_global_load_lds((const unsigned*)(wsbase + (size_t)_o), (LAS unsigned*)(lds + (bufoff) + ldsw + _i * 8192), 16, 0, 0); } } while (0)
#define PG8_LDA(dst, b, h) do { _Pragma("unroll") for (int m = 0; m < 4; ++m) _Pragma("unroll") for (int k = 0; k < 2; ++k) dst[m][k] = *(const LAS bf16x8*)(lds + PG8_SA(b, h) + aoff + m * 2048 + k * 1024); } while (0)
#define PG8_LDB(dst, b, h) do { _Pragma("unroll") for (int n = 0; n < 2; ++n) _Pragma("unroll") for (int k = 0; k < 2; ++k) dst[n][k] = *(const LAS bf16x8*)(lds + PG8_SB(b, h) + boff + n * 2048 + k * 1024); } while (0)
#define PG8_MMA(ai, bj, At, Bt) do { __builtin_amdgcn_s_setprio(1); _Pragma("unroll") for (int m = 0; m < 4; ++m) _Pragma("unroll") for (int n = 0; n < 2; ++n) _Pragma("unroll") for (int k = 0; k < 2; ++k) \
        acc[ai][bj][m][n] = __builtin_amdgcn_mfma_f32_16x16x32_bf16(Bt[n][k], At[m][k], acc[ai][bj][m][n], 0, 0, 0); __builtin_amdgcn_s_setprio(0); } while (0)
#define PG8_WAIT_V(n) asm volatile("s_waitcnt vmcnt(" #n ")" ::: "memory")
#define PG8_WAIT_L(n) asm volatile("s_waitcnt lgkmcnt(" #n ")" ::: "memory")
#define PG8_BAR __builtin_amdgcn_s_barrier()
#define PG8_SCHED __builtin_amdgcn_sched_barrier(0)
    Unit cur, nxt; int ui = 0;
    if (!S.next(0, cur)) return;
    f32x4 acc[2][2][4][2];
#pragma unroll
    for (int a = 0; a < 2; ++a)
#pragma unroll
        for (int b = 0; b < 2; ++b)
#pragma unroll
            for (int m = 0; m < 4; ++m)
#pragma unroll
                for (int n = 0; n < 2; ++n) acc[a][b][m][n] = (f32x4){0.f, 0.f, 0.f, 0.f};
    bf16x8 At[4][2], B0[2][2], B1[2][2];
    unsigned cA = S.Ap(cur), cB = S.Bp(cur);
    if constexpr (GA) { S.arows(cur, RA, CA2, cv); asm volatile("" : "+v"(cv[0][0]), "+v"(cv[0][1]), "+v"(cv[1][0]), "+v"(cv[1][1])); }
    PG8_STAGE(PG8_SB(0, 0), cB, voffB); PG8_STAGE(PG8_SB(0, 1), cB + hstep, voffB); PG8_STAGE_A(PG8_SA(0, 0), cA, 0, cv); PG8_STAGE_A(PG8_SA(0, 1), cA, 1, cv);
    if (wr == 1) PG8_BAR;
    PG8_WAIT_V(2); PG8_BAR;
    PG8_STAGE(PG8_SB(1, 0), cB + kstep, voffB); PG8_STAGE_A(PG8_SA(1, 0), cA + kstep, 0, cv); PG8_STAGE(PG8_SB(1, 1), cB + hstep + kstep, voffB);
    PG8_WAIT_V(6); PG8_BAR;
    for (;;) {
        const bool has_next = S.next(ui + 1, nxt);
        const unsigned nA = has_next ? S.Ap(nxt) : cA, nB = has_next ? S.Bp(nxt) : cB;
        if constexpr (GA) {
            if (has_next) S.arows(nxt, RA, CA2, nv); else { nv[0][0] = cv[0][0]; nv[0][1] = cv[0][1]; nv[1][0] = cv[1][0]; nv[1][1] = cv[1][1]; }
            asm volatile("" : "+v"(nv[0][0]), "+v"(nv[0][1]), "+v"(nv[1][0]), "+v"(nv[1][1])); }
        for (int t = 0; t < nt; t += 2) {
            if constexpr (Epi::MID) { if (t != 0 && (t & 15) == 0) E.mid(acc, cur, t >> 4, wr, wc, fr, fq); }
            const bool last = (t == nt - 2);
            const unsigned a1 = cA + (unsigned)(t + 1) * kstep;
            const unsigned a2 = last ? nA : cA + (unsigned)(t + 2) * kstep, b2 = last ? nB : cB + (unsigned)(t + 2) * kstep;
            const unsigned a3 = a2 + kstep, b3 = b2 + kstep;
            unsigned sv[2][2] = {{0u, 0u}, {0u, 0u}};
            if constexpr (GA) { sv[0][0] = last ? nv[0][0] : cv[0][0]; sv[0][1] = last ? nv[0][1] : cv[0][1]; sv[1][0] = last ? nv[1][0] : cv[1][0]; sv[1][1] = last ? nv[1][1] : cv[1][1]; }
            PG8_LDB(B0, 0, 0); PG8_LDB(B1, 0, 1); PG8_SCHED; PG8_LDA(At, 0, 0); PG8_STAGE_A(PG8_SA(1, 1), a1, 1, cv);
            PG8_WAIT_V(8); PG8_WAIT_L(0); PG8_BAR; PG8_MMA(0, 0, At, B0); PG8_MMA(0, 1, At, B1); PG8_BAR; PG8_SCHED;
            PG8_LDA(At, 0, 1); PG8_STAGE(PG8_SB(0, 0), b2, voffB); PG8_STAGE(PG8_SB(0, 1), b2 + hstep, voffB); PG8_STAGE_A(PG8_SA(0, 0), a2, 0, sv);
            PG8_WAIT_V(8); PG8_WAIT_L(0); PG8_BAR; PG8_MMA(1, 0, At, B0); PG8_MMA(1, 1, At, B1); PG8_BAR; PG8_SCHED;
            PG8_LDB(B0, 1, 0); PG8_LDB(B1, 1, 1); PG8_SCHED; PG8_LDA(At, 1, 0); PG8_STAGE_A(PG8_SA(0, 1), a2, 1, sv);
            PG8_WAIT_V(8); PG8_WAIT_L(0); PG8_BAR; PG8_MMA(0, 0, At, B0); PG8_MMA(0, 1, At, B1); PG8_BAR; PG8_SCHED;
            PG8_LDA(At, 1, 1); PG8_STAGE(PG8_SB(1, 0), b3, voffB); PG8_STAGE(PG8_SB(1, 1), b3 + hstep, voffB); PG8_STAGE_A(PG8_SA(1, 0), a3, 0, sv);
            PG8_WAIT_V(8); PG8_WAIT_L(0); PG8_BAR; PG8_MMA(1, 0, At, B0); PG8_MMA(1, 1, At, B1); PG8_BAR; PG8_SCHED;
        }
        if (wr == 0) PG8_BAR;
        E(acc, cur, wr, wc, fr, fq);
        if (!has_next) break;
#pragma unroll
        for (int a = 0; a < 2; ++a)
#pragma unroll
            for (int b = 0; b < 2; ++b)
#pragma unroll
                for (int m = 0; m < 4; ++m)
#pragma unroll
                    for (int n = 0; n < 2; ++n) acc[a][b][m][n] = (f32x4){0.f, 0.f, 0.f, 0.f};
        cur = nxt; cA = nA; cB = nB; ++ui;
        if constexpr (GA) { cv[0][0] = nv[0][0]; cv[0][1] = nv[0][1]; cv[1][0] = nv[1][0]; cv[1][1] = nv[1][1]; }
        if (wr == 1) PG8_BAR;
    }
    PG8_WAIT_V(0);
    PG8_BAR;
#undef PG8_SA
#undef PG8_SB
#undef PG8_STAGE
#undef PG8_STAGE_A
#undef PG8_LDA
#undef PG8_LDB
#undef PG8_MMA
#undef PG8_WAIT_V
#undef PG8_WAIT_L
#undef PG8_BAR
#undef PG8_SCHED
}

struct EpiStoreBf16 {
    static constexpr bool PERM = true, MID = false;
    bf16* O; int ldc; int remap;
    __device__ __forceinline__ void operator()(const f32x4 (&acc)[2][2][4][2], const Unit& u, int wr, int wc, int fr, int fq) const {
        const int row0 = u.pm * BM + wr * 64 + fr; int col0 = u.pn * BM + wc * 32 + 8 * fq; if (remap) col0 = (col0 >> 6) * 96 + (col0 & 63);
#pragma unroll
        for (int ai = 0; ai < 2; ++ai)
#pragma unroll
            for (int m = 0; m < 4; ++m) { bf16* rowp = O + (size_t)(row0 + ai * HALF + m * 16) * ldc + col0;
#pragma unroll
                for (int bj = 0; bj < 2; ++bj) { const f32x4 v0 = acc[ai][bj][m][0], v1 = acc[ai][bj][m][1];
                    u32x4 w; w.x = cvt_pk_bf16(v0[0], v0[1]); w.y = cvt_pk_bf16(v0[2], v0[3]); w.z = cvt_pk_bf16(v1[0], v1[1]); w.w = cvt_pk_bf16(v1[2], v1[3]);
                    *(u32x4*)(rowp + (remap ? bj * 192 : bj * HALF)) = w; } }
    }
};
struct EpiLoraWA {
    static constexpr bool PERM = false, MID = false;
    float* DEC; bf16* AA; const float* w0; const float* a0;
    __device__ __forceinline__ void operator()(const f32x4 (&acc)[2][2][4][2], const Unit& u, int wr, int wc, int fr, int fq) const {
        const int row0 = u.pm * BM + wr * 64 + fr, col0 = u.pn * BM + wc * 32 + 4 * fq;
        if (u.pn < 8) {
#pragma unroll
            for (int bj = 0; bj < 2; ++bj)
#pragma unroll
                for (int n = 0; n < 2; ++n) { const int col = col0 + bj * HALF + n * 16; const f32x4 bv = *(const f32x4*)(w0 + col);
#pragma unroll
                    for (int ai = 0; ai < 2; ++ai)
#pragma unroll
                        for (int m = 0; m < 4; ++m) { const size_t row = (size_t)(row0 + ai * HALF + m * 16); const f32x4 x = acc[ai][bj][m][n] + bv; f32x4 o;
#pragma unroll
                            for (int j = 0; j < 4; ++j) { const float y = -x[j]; const float sp = fmaxf(y, 0.f) + __logf(1.f + __expf(-fabsf(y))); o[j] = __expf(-__expf(-sp - 0.5f)); }
                            *(f32x4*)(DEC + row * 2048 + col) = o; } }
        } else {
#pragma unroll
            for (int bj = 0; bj < 2; ++bj)
#pragma unroll
                for (int n = 0; n < 2; ++n) { const int col = col0 + bj * HALF + n * 16 - 2048; const f32x4 bv = *(const f32x4*)(a0 + col);
#pragma unroll
                    for (int ai = 0; ai < 2; ++ai)
#pragma unroll
                        for (int m = 0; m < 4; ++m) { const size_t row = (size_t)(row0 + ai * HALF + m * 16); const f32x4 x = acc[ai][bj][m][n] + bv;
                            u32x2 w; w.x = pk2(sigm(x[0]), sigm(x[1])); w.y = pk2(sigm(x[2]), sigm(x[3])); *(u32x2*)(AA + row * 2048 + col) = w; } }
        }
    }
};
struct EpiBranch {
    static constexpr bool PERM = true, MID = true;
    bf16* MB; const bf16* U;
    __device__ __forceinline__ void mid(f32x4 (&acc)[2][2][4][2], const Unit& u, int zb, int wr, int wc, int fr, int fq) const {
        const int row0 = u.pm * BM + wr * 64 + fr, col0 = u.pn * BM + wc * 32 + 8 * fq;
        const bf16* ga = U + O_GATE + (zb - 1) * 2048; const bf16* gb = ga + 2048;
        const unsigned gofs0 = (unsigned)row0 * (unsigned)UW + (unsigned)col0;
#pragma unroll
        for (int ai = 0; ai < 2; ++ai)
#pragma unroll
            for (int mp = 0; mp < 2; ++mp) { u32x4 wa[2][2], wb[2][2];
                asm volatile("" ::: "memory"); unsigned gofs = gofs0; asm volatile("" : "+v"(gofs));
#pragma unroll
                for (int mi = 0; mi < 2; ++mi)
#pragma unroll
                    for (int bj = 0; bj < 2; ++bj) { const size_t o = (size_t)(gofs + (unsigned)(ai * HALF + (2 * mp + mi) * 16) * (unsigned)UW + (unsigned)(bj * HALF)); wa[mi][bj] = *(const u32x4*)(ga + o); wb[mi][bj] = *(const u32x4*)(gb + o); }
#pragma unroll
                for (int mi = 0; mi < 2; ++mi)
#pragma unroll
                    for (int bj = 0; bj < 2; ++bj) { const u32x4 a_ = wa[mi][bj], b_ = wb[mi][bj];
                        const float xa[8] = {bflo(a_.x), bfhi(a_.x), bflo(a_.y), bfhi(a_.y), bflo(a_.z), bfhi(a_.z), bflo(a_.w), bfhi(a_.w)}, xb[8] = {bflo(b_.x), bfhi(b_.x), bflo(b_.y), bfhi(b_.y), bflo(b_.z), bfhi(b_.z), bflo(b_.w), bfhi(b_.w)};
#pragma unroll
                        for (int n = 0; n < 2; ++n)
#pragma unroll
                            for (int j = 0; j < 4; ++j) acc[ai][bj][2 * mp + mi][n][j] *= fminf(1.f + __expf(-xb[4 * n + j]), 1e6f) * __builtin_amdgcn_rcpf(1.f + __expf(-xa[4 * n + j])); } }
    }
    __device__ __forceinline__ void operator()(const f32x4 (&acc)[2][2][4][2], const Unit& u, int wr, int wc, int fr, int fq) const {
        const int row0 = u.pm * BM + wr * 64 + fr, col0 = u.pn * BM + wc * 32 + 8 * fq;
        const bf16* gb = U + O_GATE + 2 * 2048;
        const unsigned gofs0 = (unsigned)row0 * (unsigned)UW + (unsigned)col0, mofs0 = (unsigned)row0 * 2048u + (unsigned)col0;
#pragma unroll
        for (int ai = 0; ai < 2; ++ai) {
            u32x4 wb[4][2];
            asm volatile("" ::: "memory"); unsigned gofs = gofs0, mofs = mofs0; asm volatile("" : "+v"(gofs), "+v"(mofs));
#pragma unroll
            for (int m = 0; m < 4; ++m)
#pragma unroll
                for (int bj = 0; bj < 2; ++bj) wb[m][bj] = *(const u32x4*)(gb + (size_t)(gofs + (unsigned)(ai * HALF + m * 16) * (unsigned)UW + (unsigned)(bj * HALF)));
#pragma unroll
            for (int m = 0; m < 4; ++m)
#pragma unroll
                for (int bj = 0; bj < 2; ++bj) { const u32x4 b_ = wb[m][bj]; const float xb[8] = {bflo(b_.x), bfhi(b_.x), bflo(b_.y), bfhi(b_.y), bflo(b_.z), bfhi(b_.z), bflo(b_.w), bfhi(b_.w)}; float v[8];
#pragma unroll
                    for (int n = 0; n < 2; ++n)
#pragma unroll
                        for (int j = 0; j < 4; ++j) v[4 * n + j] = acc[ai][bj][m][n][j] * __builtin_amdgcn_rcpf(fminf(1.f + __expf(-xb[4 * n + j]), 1e6f));
                    u32x4 w; w.x = cvt_pk_bf16(v[0], v[1]); w.y = cvt_pk_bf16(v[2], v[3]); w.z = cvt_pk_bf16(v[4], v[5]); w.w = cvt_pk_bf16(v[6], v[7]);
                    *(u32x4*)(MB + (size_t)(mofs + (unsigned)(ai * HALF + m * 16) * 2048u + (unsigned)(bj * HALF))) = w; }
        }
    }
};
struct EpiResidual {
    static constexpr bool PERM = false, MID = false;
    float* XR; const float* gate; const float* base_lat; const float* base_ctx;
    __device__ __forceinline__ void operator()(const f32x4 (&acc)[2][2][4][2], const Unit& u, int wr, int wc, int fr, int fq) const {
        const int row0 = u.pm * BM + wr * 64 + fr, col0 = u.pn * BM + wc * 32 + 4 * fq;
        const int rt = u.pm * BM; const int b = rt < ML ? rt / T : 8;
        const float* gp = gate + (size_t)b * 12288 + col0;
        const float* bp = rt < ML ? base_lat : base_ctx - (size_t)ML * D;
        const unsigned xofs0 = (unsigned)row0 * (unsigned)D + (unsigned)col0;
#pragma unroll
        for (int bj = 0; bj < 2; ++bj)
#pragma unroll
            for (int n = 0; n < 2; ++n) { const unsigned dc = (unsigned)(bj * HALF + n * 16); const f32x4 gv = *(const f32x4*)(gp + dc);
                f32x4 bv[2][4];
                asm volatile("" ::: "memory"); unsigned xofs = xofs0; asm volatile("" : "+v"(xofs));
#pragma unroll
                for (int ai = 0; ai < 2; ++ai)
#pragma unroll
                    for (int m = 0; m < 4; ++m) bv[ai][m] = *(const f32x4*)(bp + (size_t)(xofs + (unsigned)(ai * HALF + m * 16) * (unsigned)D + dc));
#pragma unroll
                for (int ai = 0; ai < 2; ++ai)
#pragma unroll
                    for (int m = 0; m < 4; ++m) *(f32x4*)(XR + (size_t)(xofs + (unsigned)(ai * HALF + m * 16) * (unsigned)D + dc)) = bv[ai][m] + gv * acc[ai][bj][m][n]; }
    }
};
struct EpiSwiglu {
    static constexpr bool PERM = true, MID = false;
    bf16* ACT;
    __device__ __forceinline__ void operator()(const f32x4 (&acc)[2][2][4][2], const Unit& u, int wr, int wc, int fr, int fq) const {
        const int row0 = u.pm * BM + wr * 64 + fr, col0 = u.pn * HALF + wc * 32 + 8 * fq;
#pragma unroll
        for (int ai = 0; ai < 2; ++ai)
#pragma unroll
            for (int m = 0; m < 4; ++m) { bf16* rowp = ACT + (size_t)(row0 + ai * HALF + m * 16) * FE + col0;
                f32x4 o0, o1;
#pragma unroll
                for (int j = 0; j < 4; ++j) { const float g0 = acc[ai][0][m][0][j], g1 = acc[ai][0][m][1][j]; o0[j] = g0 * sigm(g0) * acc[ai][1][m][0][j]; o1[j] = g1 * sigm(g1) * acc[ai][1][m][1][j]; }
                u32x4 w; w.x = cvt_pk_bf16(o0[0], o0[1]); w.y = cvt_pk_bf16(o0[2], o0[3]); w.z = cvt_pk_bf16(o1[0], o1[1]); w.w = cvt_pk_bf16(o1[2], o1[3]);
                *(u32x4*)rowp = w; }
    }
};
}

struct Frame {
    LAS unsigned char* lds;
    unsigned* ctl;
    int tid, lane, wave, G, bid;
    float* out;
    unsigned char* ws;
};
__device__ __forceinline__ const float* ld_inp(LAS unsigned char* lds, int i) {
    const volatile LAS unsigned* p = (const volatile LAS unsigned*)(lds + MISC_OFF + 256) + 2 * i;
    const unsigned lo = __builtin_amdgcn_readfirstlane(p[0]), hi = __builtin_amdgcn_readfirstlane(p[1]);
    return (const float*)(const GAS float*)(((unsigned long long)hi << 32) | lo);
}
#define INP(i) ld_inp(F.lds, (i))
#define WSP(T_, off) ((T_*)(F.ws + (off)))

__device__ __forceinline__ void tr_item(const float* W, int ldw, int k0, int n0, bf16* WT, int ldt, int drow0, int dk0, LAS float* scr, int lane) {
#pragma unroll 8
    for (int i = 0; i < 32; ++i) { const int kk = 2 * i + (lane >> 5); scr[kk * 33 + (lane & 31)] = W[(size_t)(k0 + kk) * ldw + n0 + (lane & 31)]; }
    LDS_WAIT();
    const int c = lane & 7;
#pragma unroll
    for (int j = 0; j < 4; ++j) { const int n = (lane >> 3) + 8 * j; const LAS float* s = scr + (8 * c) * 33 + n;
        u32x4 o; o.x = pk2(s[0 * 33], s[1 * 33]); o.y = pk2(s[2 * 33], s[3 * 33]); o.z = pk2(s[4 * 33], s[5 * 33]); o.w = pk2(s[6 * 33], s[7 * 33]);
        *(u32x4*)(WT + (size_t)(drow0 + n) * ldt + dk0 + k0 + 8 * c) = o; }
    LDS_WAIT();
}
__device__ __forceinline__ void convert_weights(Frame& F, int l, const int mask, const int wid, const int nw, const int tw, const int nt) {
    LAS float* scr = (LAS float*)(F.lds + F.wave * 16384);
    constexpr int I_IN = 32 * 422, I_BR = 16 * 64, I_WO = 32 * 64, I_GU = 32 * 64, I_DN = 16 * 64, I_UQ = 8 * 48, I_UKV = 4 * 64, I_LORA = 32;
    constexpr int NITEMS = I_IN + 3 * I_BR + I_WO + 16 * I_GU + 16 * I_DN + I_UQ + I_UKV + 4 * I_LORA;
    for (int it = wid; it < NITEMS; it += nw) {
        int r = it;
        if (r < I_IN) { if (!(mask & 1)) continue; const int kb = r / 422, nb = r % 422; const int n0 = 32 * nb; const int dr = n0 < 2048 ? n0 : (n0 < 3072 ? UW + n0 - 2048 : n0 - 1024);
            tr_item(INP(8) + (size_t)l * D * INW, INW, 64 * kb, n0, WSP(bf16, WS_WIN), D, dr, 0, scr, F.lane); continue; } r -= I_IN;
        if (r < 3 * I_BR) { if (!(mask & 2)) continue; const int z = r / I_BR, q = r % I_BR, kb = q / 64, nb = q % 64; tr_item(INP(25) + (size_t)(l * 3 + z) * 1024 * D, D, 64 * kb, 32 * nb, WSP(bf16, WS_WB), 3072, 32 * nb, z * 1024, scr, F.lane); continue; } r -= 3 * I_BR;
        if (r < I_WO) { if (!(mask & 4)) continue; const int kb = r / 64, nb = r % 64; tr_item(INP(26) + (size_t)l * D * D, D, 64 * kb, 32 * nb, WSP(bf16, WS_WO), D, 32 * nb, 0, scr, F.lane); continue; } r -= I_WO;
        if (r < 16 * I_GU) { if (!(mask & 8)) continue; const int e = r / I_GU, q = r % I_GU, kb = q / 64, nb = q % 64, n0 = 32 * nb; const int bj = n0 >> 10, rem = n0 & 1023, pn = rem >> 7, x0 = rem & 127;
            tr_item(INP(29) + (size_t)(l * NE + e) * D * 2048, 2048, 64 * kb, n0, WSP(bf16, WS_GU) + (size_t)e * 2048 * D, D, pn * 256 + bj * 128 + x0, 0, scr, F.lane); continue; } r -= 16 * I_GU;
        if (r < 16 * I_DN) { if (!(mask & 16)) continue; const int e = r / I_DN, q = r % I_DN, kb = q / 64, nb = q % 64; tr_item(INP(30) + (size_t)(l * NE + e) * FE * D, D, 64 * kb, 32 * nb, WSP(bf16, WS_DN) + (size_t)l * (WS_DN1 - WS_DN) / 2 + (size_t)e * D * FE, FE, 32 * nb, 0, scr, F.lane); continue; } r -= 16 * I_DN;
        if (!(mask & 32)) continue;
        if (r < I_UQ) { const int kb = r / 48, nb = r % 48; tr_item(INP(22) + (size_t)l * 512 * 1536, 1536, 64 * kb, 32 * nb, WSP(bf16, WS_WUQ), 512, 32 * nb, 0, scr, F.lane); continue; } r -= I_UQ;
        if (r < I_UKV) { const int kb = r / 64, nb = r % 64; const int n0 = 32 * nb, c0 = n0 & 127; tr_item(INP(24) + (size_t)l * 256 * 2048, 2048, 64 * kb, n0, WSP(bf16, WS_WUKV), 256, (c0 < 64 ? 0 : 1024) + (n0 >> 7) * 64 + (c0 & 63), 0, scr, F.lane); continue; } r -= I_UKV;
        { const int q4 = r / I_LORA, nb = r % I_LORA;
          const float* src = (q4 < 2 ? INP(12) : INP(14)) + (size_t)((l * 2 + (q4 & 1)) * 64) * 1024;
          tr_item(src, 1024, 0, 32 * nb, WSP(bf16, WS_WA), 256, q4 * 1024 + 32 * nb, q4 * 64, scr, F.lane); }
    }
    if (mask & 32) for (int i = tw; i < 4096 * 24; i += nt) {
        const int n = i / 24, rr = i % 24, ch = rr / 8, p = rr % 8, q = n >> 10; const int kc = ch + (ch >= q ? 1 : 0);
        *(u32x4*)(WSP(bf16, WS_WA) + (size_t)n * 256 + kc * 64 + p * 8) = (u32x4){0u, 0u, 0u, 0u}; }
    const float* gup_ = INP(15);
    if (mask & 32) for (int i = tw; i < 1024 * 256; i += nt) { const int n = i >> 8, k = i & 255; WSP(bf16, WS_WG)[i] = (bf16)(k < 160 ? f2bf(gup_[((size_t)l * 160 + k) * 1024 + n]) : 0u); }
    if (mask & 1) for (int i = tw; i < 64 * D / 8; i += nt) *(u32x4*)(WSP(bf16, WS_WIN) + (size_t)12480 * D + (size_t)i * 8) = (u32x4){0u, 0u, 0u, 0u};
}

__device__ __forceinline__ void mod_phase(Frame& F) {
    LAS float* sc = (LAS float*)F.lds;
    LAS float* red = (LAS float*)(F.lds + 73728);
    const float* c_ = INP(1); const float* cc_ = INP(3); const float* bm_ = INP(5);
    for (int i = F.tid; i < 9 * 2048; i += NTHR) { const int r = i >> 11, k = i & 2047; const float x = r < 8 ? c_[r * 2048 + k] : cc_[k]; sc[i] = x * sigm(x); }
    __syncthreads();
    for (int item = F.bid; item < 256; item += F.G) {
        const int l = item >> 7, n0 = (item & 127) * 96;
        if (F.tid < 384) {
            const int cg = F.tid % 24, kg = F.tid / 24;
            f32x4 a[9];
#pragma unroll
            for (int r = 0; r < 9; ++r) a[r] = (f32x4){0.f, 0.f, 0.f, 0.f};
            const float* wp = INP(4) + ((size_t)l * 2048 + kg * 128) * 12288 + n0 + cg * 4;
            for (int k = 0; k < 128; ++k) { const f32x4 w = *(const f32x4*)(wp + (size_t)k * 12288);
#pragma unroll
                for (int r = 0; r < 9; ++r) a[r] += w * sc[r * 2048 + kg * 128 + k]; }
#pragma unroll
            for (int r = 0; r < 9; ++r) *(LAS f32x4*)(red + (kg * 9 + r) * 96 + cg * 4) = a[r];
        }
        __syncthreads();
        for (int o = F.tid; o < 9 * 96; o += NTHR) { const int r = o / 96, c = o % 96; float s = bm_[l * 12288 + n0 + c];
#pragma unroll
            for (int kg = 0; kg < 16; ++kg) s += red[(kg * 9 + r) * 96 + c];
            WSP(float, WS_MODF)[((size_t)l * 9 + r) * 12288 + n0 + c] = s; }
        __syncthreads();
    }
}

__device__ __forceinline__ void norm_mod_store(const f32x4 (&v)[8], int lane, const float* g, const float* sc, const float* sh, bf16* orow) {
    float ss = 0.f;
#pragma unroll
    for (int j = 0; j < 8; ++j) ss += (v[j].x * v[j].x + v[j].y * v[j].y) + (v[j].z * v[j].z + v[j].w * v[j].w);
    const float rinv = rsqrtf(wave_sum(ss, lane) * (1.f / D) + 1e-6f);
#pragma unroll
    for (int j = 0; j < 8; ++j) { const int c4 = lane + 64 * j; const f32x4 gv = ((const f32x4*)g)[c4], scv = ((const f32x4*)sc)[c4], shv = ((const f32x4*)sh)[c4];
        const f32x4 h = (v[j] * rinv) * gv * (scv + 1.0f) + shv;
        u32x2 w; w.x = pk2(h.x, h.y); w.y = pk2(h.z, h.w); ((u32x2*)orow)[c4] = w; }
}

__device__ __forceinline__ float rope_inv(int i) { return __expf(-(float)i * (9.210340371976184f / 8.0f)); }

typedef short bf16x4 __attribute__((ext_vector_type(4)));
__device__ __forceinline__ bf16x4 pk4(f32x4 v) { u32x2 w; w.x = pg8::cvt_pk_bf16(v[0], v[1]); w.y = pg8::cvt_pk_bf16(v[2], v[3]); return __builtin_bit_cast(bf16x4, w); }
__device__ __forceinline__ f32x4 up4(bf16x4 b) { const u32x2 w = __builtin_bit_cast(u32x2, b); return (f32x4){bflo(w.x), bfhi(w.x), bflo(w.y), bfhi(w.y)}; }
#define MFMA16(a, b, c) __builtin_amdgcn_mfma_f32_16x16x16bf16_1k((a), (b), (c), 0, 0, 0)
constexpr int SC_P = 136;
constexpr int SL_KH = 0, SL_RH = 2176, SL_KDT = 4352, SL_BHT = 6400, SL_VT = 8448, SL_A1T = 10496, SL_X = 11008, SL_M1T = 11520, SL_M2T = 12032, SL_GC = 12544, SL_BYTES = 12800;
constexpr int SC_NS = 6;
constexpr int PV_BH = 0, PV_KDH = 2176, PV_L = 4352, PV_BYTES = 5632;
constexpr int SC_PRIV = SC_NS * SL_BYTES, SC_FLAGS = SC_PRIV + 4 * PV_BYTES;
constexpr unsigned SC_SPIN_CAP = 1u << 22;
__device__ __forceinline__ void scan_chain(LAS unsigned char* lds, const int tid, const int l, const int ch, const bf16* RS, const bf16* KS, const bf16* VS, const bf16* KKp, const _Float16* DEC, const bf16* AA,
                                           const float* kap, bf16* YSbase) {
    const int lane = tid & 63, q = __builtin_amdgcn_readfirstlane(tid >> 6), lr = lane & 15, lg = lane >> 4;
    const int z = ch >> 7, b = (ch >> 4) & 7, h = ch & 15;
    constexpr int NCH = (TC + T) / 16;
    volatile LAS int* rdy = (volatile LAS int*)(lds + SC_FLAGS); volatile LAS int* sprog = (volatile LAS int*)(lds + SC_FLAGS + 32);
    if (tid < 16) ((LAS int*)(lds + SC_FLAGS))[tid] = 0;
    __syncthreads();
    auto row0_of = [&](int c) { const int step = 16 * c; return step < TC ? ML + b * TC + (z ? TC - 1 - step : step) : b * T + (z ? T - 1 - (step - TC) : (step - TC)); };
    const int dr = z ? -1 : 1;
    if (q >= 4) {
        const int pw = q - 4;
        LAS unsigned char* PV = lds + SC_PRIV + pw * PV_BYTES;
        const int cp = lane & 31, shf = lane >> 5;
        const f32x2 ka2 = *(const f32x2*)(kap + h * 64 + 2 * cp);
        unsigned rw[8], pa[8], pr[8], pkk[8], pk[8], pv[8];
        auto pload = [&](int c) { const int r0 = row0_of(c) + dr * 8 * shf;
            const long o1 = (long)r0 * 1024 + h * 64 + 2 * cp, o2 = (long)r0 * 2048 + z * 1024 + h * 64 + 2 * cp; const long s1 = (long)dr * 1024, s2 = (long)dr * 2048;
#pragma unroll
            for (int j = 0; j < 8; ++j) { rw[j] = *(const unsigned*)(DEC + o2 + j * s2); pa[j] = *(const unsigned*)(AA + o2 + j * s2); pr[j] = *(const unsigned*)(RS + o1 + j * s1);
                pkk[j] = *(const unsigned*)(KKp + o1 + j * s1); pk[j] = *(const unsigned*)(KS + o1 + j * s1); pv[j] = *(const unsigned*)(VS + o1 + j * s1); } };
        if (pw < NCH) pload(pw);
        for (int c = pw; c < NCH; c += 4) {
            LAS unsigned char* SB = lds + (c % SC_NS) * SL_BYTES;
            if (c >= SC_NS) { const int need = c - SC_NS + 1; unsigned sp = 0;
                for (;;) { const int a0 = sprog[0], a1 = sprog[1], a2 = sprog[2], a3 = sprog[3]; const int mn = min(min(a0, a1), min(a2, a3)); if (mn >= need || ++sp > SC_SPIN_CAP) break; __builtin_amdgcn_s_sleep(1); } }
            asm volatile("" ::: "memory");
            { float g0 = 1.f, g1 = 1.f;
#pragma unroll
              for (int j = 0; j < 8; ++j) { g0 *= h2lo(rw[j]); g1 *= h2hi(rw[j]); }
              const float o0 = shx(g0, 32, lane), o1_ = shx(g1, 32, lane);
              g0 = shf ? o0 : 1.f; g1 = shf ? o1_ : 1.f;
              unsigned kdq0[4], kdq1[4], bq0[4], bq1[4];
              float kd0p = 0.f, kd1p = 0.f, b0p = 0.f, b1p = 0.f;
#pragma unroll
              for (int j = 0; j < 8; ++j) { const int t = 8 * shf + j; const float gp0 = g0, gp1 = g1; g0 *= h2lo(rw[j]); g1 *= h2hi(rw[j]);
                  const float kk0 = bflo(pkk[j]), kk1 = bfhi(pkk[j]), a0 = bflo(pa[j]), a1 = bfhi(pa[j]); const float i0 = __builtin_amdgcn_rcpf(g0), i1 = __builtin_amdgcn_rcpf(g1);
                  const float bh0 = kk0 * a0 * i0, bh1 = kk1 * a1 * i1, kd0 = bflo(pk[j]) * (1.f + (a0 - 1.f) * ka2.x) * i0, kd1 = bfhi(pk[j]) * (1.f + (a1 - 1.f) * ka2.y) * i1;
                  *(LAS unsigned*)(SB + SL_KH + t * SC_P + cp * 4) = pk2(kk0 * gp0, kk1 * gp1); *(LAS unsigned*)(SB + SL_RH + t * SC_P + cp * 4) = pk2(bflo(pr[j]) * g0, bfhi(pr[j]) * g1);
                  *(LAS unsigned*)(PV + PV_BH + t * SC_P + cp * 4) = pk2(bh0, bh1); *(LAS unsigned*)(PV + PV_KDH + t * SC_P + cp * 4) = pk2(kd0, kd1);
                  if (j & 1) { kdq0[j >> 1] = pk2(kd0p, kd0); kdq1[j >> 1] = pk2(kd1p, kd1); bq0[j >> 1] = pk2(b0p, bh0); bq1[j >> 1] = pk2(b1p, bh1); } else { kd0p = kd0; kd1p = kd1; b0p = bh0; b1p = bh1; } }
              if (shf) *(LAS f32x2*)(SB + SL_GC + cp * 8) = (f32x2){g0, g1};
              *(LAS u32x4*)(SB + SL_KDT + (2 * cp) * 32 + shf * 16) = (u32x4){kdq0[0], kdq0[1], kdq0[2], kdq0[3]}; *(LAS u32x4*)(SB + SL_KDT + (2 * cp + 1) * 32 + shf * 16) = (u32x4){kdq1[0], kdq1[1], kdq1[2], kdq1[3]};
              *(LAS u32x4*)(SB + SL_BHT + (2 * cp) * 32 + shf * 16) = (u32x4){bq0[0], bq0[1], bq0[2], bq0[3]}; *(LAS u32x4*)(SB + SL_BHT + (2 * cp + 1) * 32 + shf * 16) = (u32x4){bq1[0], bq1[1], bq1[2], bq1[3]};
              u32x4 v0_, v1_;
#pragma unroll
              for (int m = 0; m < 4; ++m) { v0_[m] = (pv[2 * m] & 0xffffu) | (pv[2 * m + 1] << 16); v1_[m] = (pv[2 * m] >> 16) | (pv[2 * m + 1] & 0xffff0000u); }
              *(LAS u32x4*)(SB + SL_VT + (2 * cp) * 32 + shf * 16) = v0_; *(LAS u32x4*)(SB + SL_VT + (2 * cp + 1) * 32 + shf * 16) = v1_; }
            if (c + 4 < NCH) pload(c + 4);
            LDS_WAIT();
#pragma unroll
            for (int gi = 0; gi < 4; ++gi) {
                const LAS unsigned char* Aarr = PV + ((gi & 1) ? PV_KDH : PV_BH); const LAS unsigned char* Barr = SB + ((gi < 2) ? SL_KH : SL_RH);
                f32x4 acc = (f32x4){0.f, 0.f, 0.f, 0.f};
#pragma unroll
                for (int kt = 0; kt < 4; ++kt) acc = MFMA16(*(const LAS bf16x4*)(Aarr + lr * SC_P + (16 * kt + 4 * lg) * 2), *(const LAS bf16x4*)(Barr + lr * SC_P + (16 * kt + 4 * lg) * 2), acc);
#pragma unroll
                for (int i = 0; i < 4; ++i) { const int j = 4 * lg + i; const bool keep = (gi < 2) ? (j < lr) : (j <= lr); acc[i] = keep ? acc[i] : 0.f; }
                if (gi == 0) {
#pragma unroll
                    for (int i = 0; i < 4; ++i) *(LAS float*)(PV + PV_L + (4 * lg + i) * 64 + lr * 4) = acc[i]; }
                else *(LAS bf16x4*)(SB + (gi == 1 ? SL_A1T : (gi == 2 ? SL_M2T : SL_M1T)) + lr * 32 + lg * 8) = pk4(acc);
            }
            LDS_WAIT();
            { float X[16];
#pragma unroll
              for (int t = 0; t < 16; ++t) X[t] = (t == lr) ? 1.f : 0.f;
#pragma unroll
              for (int j = 0; j < 15; ++j) {
                  f32x4 aq[4];
#pragma unroll
                  for (int tq = (j + 1) >> 2; tq < 4; ++tq) aq[tq] = *(const LAS f32x4*)(PV + PV_L + j * 64 + tq * 16);
#pragma unroll
                  for (int t = j + 1; t < 16; ++t) X[t] -= aq[t >> 2][t & 3] * X[j];
              }
              if (lane < 16) {
#pragma unroll
                  for (int t = 0; t < 16; ++t) *(LAS bf16*)(SB + SL_X + t * 32 + lr * 2) = (bf16)f2bf(X[t]); } }
            LDS_WAIT();
            if (lane == 0) rdy[c % SC_NS] = c + 1;
        }
    } else {
        bf16* YS = YSbase + (size_t)z * M * 1024 + h * 64 + 16 * q + lr;
        f32x4 S[4];
#pragma unroll
        for (int kt = 0; kt < 4; ++kt) S[kt] = (f32x4){0.f, 0.f, 0.f, 0.f};
        for (int c = 0; c < NCH; ++c) {
            const LAS unsigned char* SB = lds + (c % SC_NS) * SL_BYTES;
            { unsigned sp = 0; while (rdy[c % SC_NS] != c + 1 && ++sp <= SC_SPIN_CAP) __builtin_amdgcn_s_sleep(1); }
            asm volatile("" ::: "memory");
            bf16x4 hi[4], lo[4];
#pragma unroll
            for (int kt = 0; kt < 4; ++kt) { hi[kt] = pk4(S[kt]); lo[kt] = pk4(S[kt] - up4(hi[kt])); }
            f32x4 g4 = (f32x4){0.f, 0.f, 0.f, 0.f}, yq = (f32x4){0.f, 0.f, 0.f, 0.f};
#pragma unroll
            for (int kt = 0; kt < 4; ++kt) { const bf16x4 ak = *(const LAS bf16x4*)(SB + SL_KH + lr * SC_P + (16 * kt + 4 * lg) * 2), ar = *(const LAS bf16x4*)(SB + SL_RH + lr * SC_P + (16 * kt + 4 * lg) * 2);
                g4 = MFMA16(ak, hi[kt], g4); g4 = MFMA16(ak, lo[kt], g4); yq = MFMA16(ar, hi[kt], yq); yq = MFMA16(ar, lo[kt], yq); }
            const bf16x4 vt = *(const LAS bf16x4*)(SB + SL_VT + (16 * q + lr) * 32 + lg * 8);
            const f32x4 hT = MFMA16(*(const LAS bf16x4*)(SB + SL_A1T + lr * 32 + lg * 8), vt, g4);
            const bf16x4 hb = pk4(hT), hl = pk4(hT - up4(hb));
            const bf16x4 xf = *(const LAS bf16x4*)(SB + SL_X + lr * 32 + lg * 8);
            f32x4 uT = MFMA16(xf, hb, ((f32x4){0.f, 0.f, 0.f, 0.f})); uT = MFMA16(xf, hl, uT);
            const u32x2 ubw = __builtin_bit_cast(u32x2, pk4(uT));
            const bf16x4 nub = __builtin_bit_cast(bf16x4, ((u32x2){ubw.x ^ 0x80008000u, ubw.y ^ 0x80008000u}));
            f32x4 yT = MFMA16(*(const LAS bf16x4*)(SB + SL_M1T + lr * 32 + lg * 8), vt, yq);
            yT = MFMA16(*(const LAS bf16x4*)(SB + SL_M2T + lr * 32 + lg * 8), nub, yT);
            { const long yo = (long)row0_of(c) * 1024, ys = (long)dr * 1024;
#pragma unroll
              for (int i = 0; i < 4; ++i) YS[yo + (4 * lg + i) * ys] = (bf16)f2bf(yT[i]); }
#pragma unroll
            for (int kt = 0; kt < 4; ++kt) {
                S[kt] = MFMA16(*(const LAS bf16x4*)(SB + SL_KDT + (16 * kt + lr) * 32 + lg * 8), vt, S[kt]);
                S[kt] = MFMA16(*(const LAS bf16x4*)(SB + SL_BHT + (16 * kt + lr) * 32 + lg * 8), nub, S[kt]);
                S[kt] = S[kt] * *(const LAS f32x4*)(SB + SL_GC + (16 * kt + 4 * lg) * 4); }
            LDS_WAIT();
            if (lane == 0) sprog[q] = c + 1;
        }
    }
}

typedef float f32x16 __attribute__((ext_vector_type(16)));
constexpr int ATT_VP = 136, ATT_VBYTES = 64 * ATT_VP, ATT_RPB_OFF = 49152;
template <int DQK, int MODE>
__device__ __forceinline__ void attn_unit(LAS unsigned char* lds, const int tid, const bf16* Qp, const int qpitch, const float qscale, const int tq0,
                                          const bf16* Kp, const int kpitch, const bf16* VTp, const int vtpitch, const int nA, const int tA, const int nB, const int tB, bf16* Op,
                                          const float* rpb_h, const int i0, const int rlo) {
    constexpr int KP = DQK * 2 + 16, KBYTES = 64 * KP, CPR = DQK / 8, NKS = DQK / 16;
    constexpr int VOFF = 2 * KBYTES;
    const int lane = tid & 63, w = __builtin_amdgcn_readfirstlane(tid >> 6), c = lane & 31, hf = lane >> 5;
    LAS float* RPB = (LAS float*)(lds + ATT_RPB_OFF);
    if (MODE == 2) { for (int i = tid; i < 15 * 31; i += NTHR) RPB[i] = rpb_h[i] * 1.4426950408889634f; }
    bf16x8 qf[NKS];
    {
        const bf16* qrow = Qp + (size_t)(32 * w + c) * qpitch;
        const int tq = tq0 + 32 * w + c;
#pragma unroll
        for (int ks = 0; ks < NKS; ++ks) {
            const u32x4 raw = *(const u32x4*)(qrow + 16 * ks + 8 * hf);
            float f[8] = {bflo(raw.x), bfhi(raw.x), bflo(raw.y), bfhi(raw.y), bflo(raw.z), bfhi(raw.z), bflo(raw.w), bfhi(raw.w)};
            if (MODE == 1 && ks >= 4) {
                const float pos = (float)(ks == 4 ? (tq >> 6) : (tq & 63));
#pragma unroll
                for (int j = 0; j < 8; ++j) { const float p = shx(f[j], 32, lane); const float ang = pos * rope_inv(j); const float sn = __sinf(ang), cs = __cosf(ang); f[j] = hf ? (p * sn + f[j] * cs) : (f[j] * cs - p * sn); }
            }
            u32x4 o; o.x = pk2(f[0] * qscale, f[1] * qscale); o.y = pk2(f[2] * qscale, f[3] * qscale); o.z = pk2(f[4] * qscale, f[5] * qscale); o.w = pk2(f[6] * qscale, f[7] * qscale);
            qf[ks] = __builtin_bit_cast(bf16x8, o);
        }
    }
    const int jq = (32 * w + c) & 63, iw = i0 + (w >> 1);
    int r0w = iw - 4; r0w = r0w < 0 ? 0 : (r0w > 24 ? 24 : r0w);
    int cs0 = jq - 8; cs0 = cs0 < 0 ? 0 : (cs0 > 48 ? 48 : cs0);
    const int krow = tid / CPR, kcc = tid % CPR, krow2 = (tid + 512) / CPR, kcc2 = (tid + 512) % CPR, vdv = tid >> 3, vcc = tid & 7;
    u32x4 pk0[2], pk1[2], pv[2];
    int ntl = nA + nB; asm volatile("" : "+s"(ntl));
#define ATT_GLOAD(t_, S_) do { const int T0_ = (t_) < nA ? tA + 64 * (t_) : tB + 64 * ((t_) - nA); \
        pk0[S_] = *(const u32x4*)(Kp + (size_t)(T0_ + krow) * kpitch + kcc * 8); \
        if (DQK == 96 && tid < 256) pk1[S_] = *(const u32x4*)(Kp + (size_t)(T0_ + krow2) * kpitch + kcc2 * 8); \
        pv[S_] = *(const u32x4*)(VTp + (size_t)vdv * vtpitch + T0_ + vcc * 8); } while (0)
#define ATT_LSTORE(buf_, S_) do { \
        *(LAS u32x4*)(lds + (buf_) * KBYTES + krow * KP + kcc * 16) = pk0[S_]; \
        if (DQK == 96 && tid < 256) *(LAS u32x4*)(lds + (buf_) * KBYTES + krow2 * KP + kcc2 * 16) = pk1[S_]; \
        LAS u32x2* vd_ = (LAS u32x2*)(lds + VOFF + (buf_) * ATT_VBYTES + vdv * ATT_VP + vcc * 16); vd_[0] = (u32x2){pv[S_].x, pv[S_].y}; vd_[1] = (u32x2){pv[S_].z, pv[S_].w}; } while (0)
    float m = -1e30f, lsum = 0.f;
    f32x16 o0, o1;
#pragma unroll
    for (int r = 0; r < 16; ++r) { o0[r] = 0.f; o1[r] = 0.f; }
    auto compute = [&](const int t, const int buf) {
        const int kr = rlo + t;
        const bool active = (MODE != 2) || (t >= nA) || (kr >= r0w && kr < r0w + 8);
        if (active) {
            const LAS unsigned char* KL = lds + buf * KBYTES; const LAS unsigned char* VL = lds + VOFF + buf * ATT_VBYTES;
            f32x16 s0, s1;
#pragma unroll
            for (int r = 0; r < 16; ++r) { s0[r] = 0.f; s1[r] = 0.f; }
#pragma unroll
            for (int ks = 0; ks < NKS; ++ks) {
                const bf16x8 k0 = *(const LAS bf16x8*)(KL + c * KP + (16 * ks + 8 * hf) * 2);
                const bf16x8 k1 = *(const LAS bf16x8*)(KL + (32 + c) * KP + (16 * ks + 8 * hf) * 2);
                s0 = __builtin_amdgcn_mfma_f32_32x32x16_bf16(k0, qf[ks], s0, 0, 0, 0);
                s1 = __builtin_amdgcn_mfma_f32_32x32x16_bf16(k1, qf[ks], s1, 0, 0, 0);
            }
            if (MODE == 2 && t < nA) {
                const LAS float* rb = RPB + (kr - iw + 7) * 31 + 15 - jq;
                { float bb[16];
#pragma unroll
                  for (int r = 0; r < 16; ++r) bb[r] = rb[(r & 3) + 8 * (r >> 2) + 4 * hf];
#pragma unroll
                  for (int r = 0; r < 16; ++r) asm volatile("" : "+v"(bb[r]));
#pragma unroll
                  for (int r = 0; r < 16; ++r) { const int kc = (r & 3) + 8 * (r >> 2) + 4 * hf; s0[r] = ((kc >= cs0) && (kc < cs0 + 16)) ? s0[r] + bb[r] : -1e30f; } }
                { float bb[16];
#pragma unroll
                  for (int r = 0; r < 16; ++r) bb[r] = rb[32 + (r & 3) + 8 * (r >> 2) + 4 * hf];
#pragma unroll
                  for (int r = 0; r < 16; ++r) asm volatile("" : "+v"(bb[r]));
#pragma unroll
                  for (int r = 0; r < 16; ++r) { const int kc = 32 + (r & 3) + 8 * (r >> 2) + 4 * hf; s1[r] = ((kc >= cs0) && (kc < cs0 + 16)) ? s1[r] + bb[r] : -1e30f; } }
            }
            float mx = s0[0];
#pragma unroll
            for (int r = 1; r < 16; ++r) mx = fmaxf(mx, s0[r]);
#pragma unroll
            for (int r = 0; r < 16; ++r) mx = fmaxf(mx, s1[r]);
            mx = fmaxf(mx, shx(mx, 32, lane));
            const float mn = (mx > m + 8.f) ? mx : m, alpha = __builtin_amdgcn_exp2f(m - mn);
            m = mn;
            float rs = 0.f;
#pragma unroll
            for (int r = 0; r < 16; ++r) { s0[r] = __builtin_amdgcn_exp2f(s0[r] - mn); s1[r] = __builtin_amdgcn_exp2f(s1[r] - mn); rs += s0[r] + s1[r]; }
            lsum = lsum * alpha + rs;
            if (__any(alpha != 1.f)) {
#pragma unroll
                for (int r = 0; r < 16; ++r) { o0[r] *= alpha; o1[r] *= alpha; } }
            bf16x8 pf[2][2];
#pragma unroll
            for (int st = 0; st < 2; ++st) {
                u32x4 a; a.x = pk2(s0[8 * st + 0], s0[8 * st + 1]); a.y = pk2(s0[8 * st + 2], s0[8 * st + 3]); a.z = pk2(s0[8 * st + 4], s0[8 * st + 5]); a.w = pk2(s0[8 * st + 6], s0[8 * st + 7]);
                u32x4 b; b.x = pk2(s1[8 * st + 0], s1[8 * st + 1]); b.y = pk2(s1[8 * st + 2], s1[8 * st + 3]); b.z = pk2(s1[8 * st + 4], s1[8 * st + 5]); b.w = pk2(s1[8 * st + 6], s1[8 * st + 7]);
                pf[0][st] = __builtin_bit_cast(bf16x8, a); pf[1][st] = __builtin_bit_cast(bf16x8, b);
            }
#pragma unroll
            for (int kb = 0; kb < 2; ++kb)
#pragma unroll
                for (int st = 0; st < 2; ++st) {
                    const int ko = (32 * kb + 16 * st + 4 * hf) * 2;
                    const u32x2 a0 = *(const LAS u32x2*)(VL + c * ATT_VP + ko), a1 = *(const LAS u32x2*)(VL + c * ATT_VP + ko + 16);
                    const u32x2 b0 = *(const LAS u32x2*)(VL + (32 + c) * ATT_VP + ko), b1 = *(const LAS u32x2*)(VL + (32 + c) * ATT_VP + ko + 16);
                    const bf16x8 v0 = __builtin_bit_cast(bf16x8, (u32x4){a0.x, a0.y, a1.x, a1.y}), v1 = __builtin_bit_cast(bf16x8, (u32x4){b0.x, b0.y, b1.x, b1.y});
                    o0 = __builtin_amdgcn_mfma_f32_32x32x16_bf16(v0, pf[kb][st], o0, 0, 0, 0);
                    o1 = __builtin_amdgcn_mfma_f32_32x32x16_bf16(v1, pf[kb][st], o1, 0, 0, 0);
                }
        }
    };
    ATT_GLOAD(0, 0); ATT_LSTORE(0, 0);
    if (ntl > 1) ATT_GLOAD(1, 1);
    __syncthreads();
    for (int t = 0; t < ntl; t += 2) {
        if (t + 2 < ntl) ATT_GLOAD(t + 2, 0);
        compute(t, 0);
        if (t + 1 < ntl) ATT_LSTORE(1, 1);
        __syncthreads();
        if (t + 1 >= ntl) break;
        if (t + 3 < ntl) ATT_GLOAD(t + 3, 1);
        compute(t + 1, 1);
        if (t + 2 < ntl) ATT_LSTORE(0, 0);
        __syncthreads();
    }
#undef ATT_GLOAD
#undef ATT_LSTORE
    lsum += shx(lsum, 32, lane);
    const float inv = __builtin_amdgcn_rcpf(lsum);
    bf16* orow = Op + (size_t)(32 * w + c) * 3072;
#pragma unroll
    for (int g = 0; g < 4; ++g) {
        u32x2 a; a.x = pk2(o0[4 * g] * inv, o0[4 * g + 1] * inv); a.y = pk2(o0[4 * g + 2] * inv, o0[4 * g + 3] * inv);
        u32x2 b; b.x = pk2(o1[4 * g] * inv, o1[4 * g + 1] * inv); b.y = pk2(o1[4 * g + 2] * inv, o1[4 * g + 3] * inv);
        *(u32x2*)(orow + 8 * g + 4 * hf) = a; *(u32x2*)(orow + 32 + 8 * g + 4 * hf) = b;
    }
}

struct Args { const float* in[32]; float* out; unsigned char* ws; int ph_lo, ph_hi; };

template <unsigned PM>
__global__ void __launch_bounds__(NTHR, 2) fwd_kernel(Args args) {
    extern __shared__ __attribute__((aligned(16))) unsigned char lds_raw[];
    LAS unsigned char* const lds0 = (LAS unsigned char*)lds_raw;
    unsigned char* const ws0 = args.ws; float* const out0 = args.out;
    {
        const int t0 = threadIdx.x;
        for (int u = t0; u < (LDS_BYTES - RING_BYTES) / 4; u += NTHR) ((LAS unsigned*)(lds0 + RING_BYTES))[u] = 0u;
        __syncthreads();
        if (t0 == 0) {
#pragma unroll
            for (int i = 0; i < 32; ++i) ((volatile LAS unsigned long long*)(lds0 + MISC_OFF + 256))[i] = (unsigned long long)args.in[i];
        }
        __syncthreads();
    }
    const int lo = args.ph_lo, hi = args.ph_hi;
    XcdBarrier bar; bar.bar = (unsigned*)(ws0 + WS_CTL) + CW_BAR; bar.x = 0; bar.st = nullptr;
    if (hi - lo > 1) bar = xcd_barrier_post((unsigned*)(ws0 + WS_CTL) + CW_BAR, (volatile LAS unsigned*)(lds0 + MISC_OFF) + 8);
#define IN(k) (lo <= (k) && (k) < hi)
#define SEAM(k) do { if (IN(k) && IN((k) + 1)) { XcdBarrier b2 = bar; asm volatile("" : "+s"(b2.bar)); xcd_barrier(b2); } } while (0)
#define FRAME() Frame F; { int tz = threadIdx.x; asm volatile("" : "+v"(tz)); size_t zo = 0; asm volatile("" : "+s"(zo)); unsigned char* wz = ws0 + zo; \
    F.lds = lds0; F.tid = tz; F.lane = tz & 63; F.wave = __builtin_amdgcn_readfirstlane(tz >> 6); F.G = gridDim.x; F.bid = blockIdx.x; F.out = out0; F.ws = wz; F.ctl = (unsigned*)(wz + WS_CTL); } \
    const int gw = F.bid * NWAVES + F.wave, NGW = F.G * NWAVES, lane = F.lane; (void)gw; (void)NGW; (void)lane

    if (PHEN(0) && IN(0)) REPL(0) {
        FRAME();
        mod_phase(F);
        convert_weights(F, 0, 63, F.bid * NWAVES + F.wave, F.G * NWAVES, F.bid * NTHR + F.tid, F.G * NTHR);
    }
    SEAM(0);

    for (int l = 0; l < 2; ++l) {
        const int pb = 1 + l * PH_PER_LAYER;
        const int Mrows = (l == 0) ? M : ML;

        if (PHEN(1) && IN(pb + 0) && l == 0) {
            FRAME();
            const float* MODL = WSP(float, WS_MODF) + (size_t)l * 9 * 12288; (void)MODL;
            const float* n1g_ = INP(6) + l * D; const float* xin_ = INP(0); const float* cin_ = INP(2);
            {
              const float* rwp = INP(27); const float* n2g = INP(7); bf16* WRB = WSP(bf16, WS_WRB); float* CB = WSP(float, WS_CB);
              for (int i = F.bid * NTHR + F.tid; i < 2 * 9 * 16 * D; i += F.G * NTHR) { const int k = i & 2047, e = (i >> 11) & 15, lb = i >> 15, b2 = lb % 9, l2 = lb / 9;
                  const float* md = WSP(float, WS_MODF) + ((size_t)l2 * 9 + b2) * 12288;
                  const float w = n2g[l2 * D + k] * (1.f + md[8192 + k]) * rwp[(size_t)k * 16 + e]; const unsigned hi = f2bf(w);
                  bf16* dst = WRB + ((size_t)lb * 2 * 16 + e) * D + k; dst[0] = (bf16)hi; dst[16 * D] = (bf16)f2bf(w - bf2f((bf16)hi)); }
              for (int wv_ = gw; wv_ < 2 * 9 * 16; wv_ += NGW) { const int e = wv_ & 15, lb = wv_ >> 4; const float* md = WSP(float, WS_MODF) + (size_t)lb * 12288 + 6144; float a_ = 0.f;
                  for (int k = lane; k < D; k += 64) a_ += md[k] * rwp[(size_t)k * 16 + e];
                  a_ = wave_sum(a_, lane); if (lane == 0) CB[wv_] = a_; } }
            { const bool split = (NGW == 2048);
              for (int it = 0; ; ++it) {
                int rowbase, R;
                if (!split) { const int tile = gw + it * NGW; if (tile >= M / 8) break; rowbase = tile * 8; R = 8; }
                else if (it == 0) { rowbase = gw * 8; R = 8; }
                else if (it == 1 && F.wave < 2) { const int hh_ = F.bid * 2 + F.wave; rowbase = (2048 + (hh_ >> 1)) * 8 + (hh_ & 1) * 4; R = 4; }
                else break;
                const int b = rowbase < ML ? rowbase / T : 8;
                const f32x4* sc = (const f32x4*)(MODL + (size_t)b * 12288 + 2048); const f32x4* sh = (const f32x4*)(MODL + (size_t)b * 12288);
                f32x4 ga[8], gs[8];
#pragma unroll
                for (int j = 0; j < 8; ++j) { const int c4 = lane + 64 * j; ga[j] = ((const f32x4*)n1g_)[c4] * (sc[c4] + 1.0f); gs[j] = sh[c4]; }
#pragma unroll 2
                for (int r = 0; r < R; ++r) { const int row = rowbase + r;
                    const f32x4* xr = row < ML ? (const f32x4*)xin_ + (size_t)row * (D / 4) : (const f32x4*)cin_ + (size_t)(row - ML) * (D / 4);
                    f32x4 v[8]; float ss = 0.f;
#pragma unroll
                    for (int j = 0; j < 8; ++j) { v[j] = xr[lane + 64 * j]; ss += (v[j].x * v[j].x + v[j].y * v[j].y) + (v[j].z * v[j].z + v[j].w * v[j].w); }
                    const float ri = rsqrtf(wave_sum(ss, lane) * (1.f / D) + 1e-6f);
#pragma unroll
                    for (int j = 0; j < 8; ++j) { const int c4 = lane + 64 * j; const f32x4 hh = (v[j] * ri) * ga[j] + gs[j];
                        u32x2 w; w.x = pk2(hh.x, hh.y); w.y = pk2(hh.z, hh.w); ((u32x2*)(WSP(bf16, WS_H) + (size_t)row * D))[c4] = w; } }
              } }
        }
        if (l == 0) SEAM(pb + 0);

        if (PHEN(2) && IN(pb + 1)) REPL(2) {
            FRAME();
            const float* MODL = WSP(float, WS_MODF) + (size_t)l * 9 * 12288; (void)MODL;
            pg8::SchedWin S; S.H = (unsigned)WS_H; S.W = (unsigned)WS_WIN; S.Wv = (unsigned)(WS_WIN + (size_t)UW * D * 2); S.tstep = 256u * D * 2; S.n1 = (M / 256) * (UW / 256); S.G = F.G; S.c = F.bid; S.last = (l == 1);
            pg8::EpiWin E{WSP(bf16, WS_BIG), WSP(bf16, WS_VTN)};
            pg8::gemm_phase(F.lds, F.ws, D, S, E);
        }
        SEAM(pb + 1);

        if (PHEN(3) && IN(pb + 2)) REPL(3) {
            FRAME();
            const bf16* U = WSP(bf16, WS_BIG);
            LAS float* cmu = (LAS float*)F.lds; LAS float* ckk = cmu + 3488; LAS float* cqg = ckk + 1024; LAS float* ckg = cqg + 512;
            { const float* mu = INP(10) + (size_t)l * 3488; const float* kkw_ = INP(16) + l * 1024; const float* qng_ = INP(21) + l * 512; const float* kvg_ = INP(23) + l * 256;
              for (int i = F.tid; i < 3488; i += NTHR) cmu[i] = mu[i];
              for (int i = F.tid; i < 1024; i += NTHR) ckk[i] = kkw_[i];
              for (int i = F.tid; i < 512; i += NTHR) cqg[i] = qng_[i];
              for (int i = F.tid; i < 256; i += NTHR) ckg[i] = kvg_[i]; }
            __syncthreads();
            const int rpw = (M + NGW - 1) / NGW;
            for (int row = gw * rpw; row < min(M, (gw + 1) * rpw); ++row) {
                int t, tlen; if (row < ML) { t = row % T; tlen = T; } else { t = (row - ML) % TC; tlen = TC; }
                const bool hp = t > 0, hn = t < tlen - 1;
                const bf16* u0 = U + (size_t)row * UW + O_RW;
                const bf16* up = u0 - UW; const bf16* un = u0 + UW;
                unsigned W0[28], WP[28], WN[28], CQw[4], CKw[2];
#pragma unroll
                for (int p = 0; p < 28; ++p) { const int c = p < 24 ? (p >> 3) * 1024 + 128 * (p & 7) + 2 * lane : (p == 24 ? 3072 : (p == 25 ? 3200 : (p == 26 ? 3328 : 3456))) + 2 * lane;
                    const bool in = (p < 27) || (lane < 16);
                    W0[p] = in ? *(const unsigned*)(u0 + c) : 0u; WP[p] = (in && hp) ? *(const unsigned*)(up + c) : 0u; WN[p] = (in && hn) ? *(const unsigned*)(un + c) : 0u; }
#pragma unroll
                for (int j = 0; j < 4; ++j) CQw[j] = *(const unsigned*)(U + (size_t)row * UW + O_CQ + 128 * j + 2 * lane);
#pragma unroll
                for (int j = 0; j < 2; ++j) CKw[j] = *(const unsigned*)(U + (size_t)row * UW + O_CKV + 128 * j + 2 * lane);
                float xkr = bf2f(U[(size_t)row * UW + O_KR + (lane & 31)]);
                auto sh2 = [&](int p, int c, float& s0, float& s1) {
                    const float a0 = bflo(W0[p]), a1 = bfhi(W0[p]);
                    s0 = a0 + cmu[c] * (0.5f * (bflo(WP[p]) + bflo(WN[p])) - a0); s1 = a1 + cmu[c + 1] * (0.5f * (bfhi(WP[p]) + bfhi(WN[p])) - a1); };
#pragma unroll
                for (int j = 0; j < 8; ++j) { const int c = 128 * j + 2 * lane; float r0, r1, k0, k1, v0, v1;
                    sh2(j, c, r0, r1); sh2(8 + j, 1024 + c, k0, k1); sh2(16 + j, 2048 + c, v0, v1);
                    *(unsigned*)(WSP(bf16, WS_RS) + (size_t)row * 1024 + c) = pk2(r0, r1);
                    *(unsigned*)(WSP(bf16, WS_KS) + (size_t)row * 1024 + c) = pk2(k0, k1);
                    *(unsigned*)(WSP(bf16, WS_VS) + (size_t)row * 1024 + c) = pk2(v0, v1);
                    const float kk0 = k0 * ckk[c], kk1 = k1 * ckk[c + 1];
                    const float nn = half_sum(kk0 * kk0 + kk1 * kk1, lane); const float inv = __builtin_amdgcn_rsqf(fmaxf(nn, 1e-24f));
                    *(unsigned*)(WSP(bf16, WS_KK) + (size_t)row * 1024 + c) = pk2(kk0 * inv, kk1 * inv); }
                { float s0, s1; sh2(24, 3072 + 2 * lane, s0, s1); *(unsigned*)(WSP(bf16, WS_LA) + (size_t)row * 256 + 2 * lane) = pk2(1.f - 2.f * __builtin_amdgcn_rcpf(1.f + __expf(2.f * s0)), 1.f - 2.f * __builtin_amdgcn_rcpf(1.f + __expf(2.f * s1)));
                  sh2(25, 3200 + 2 * lane, s0, s1); *(unsigned*)(WSP(bf16, WS_LA) + (size_t)row * 256 + 128 + 2 * lane) = pk2(s0, s1); }
                { float s0, s1; sh2(26, 3328 + 2 * lane, s0, s1); *(unsigned*)(WSP(bf16, WS_LG) + (size_t)row * 256 + 2 * lane) = pk2(sigm(s0), sigm(s1));
                  unsigned w = 0u; if (lane < 16) { sh2(27, 3456 + 2 * lane, s0, s1); w = pk2(sigm(s0), sigm(s1)); }
                  *(unsigned*)(WSP(bf16, WS_LG) + (size_t)row * 256 + 128 + 2 * lane) = w; }
                { float x[8]; float ss = 0.f;
#pragma unroll
                  for (int j = 0; j < 4; ++j) { x[2 * j] = bflo(CQw[j]); x[2 * j + 1] = bfhi(CQw[j]); ss += x[2 * j] * x[2 * j] + x[2 * j + 1] * x[2 * j + 1]; }
                  const float rinv = rsqrtf(wave_sum(ss, lane) * (1.f / 512.f) + 1e-6f);
#pragma unroll
                  for (int j = 0; j < 4; ++j) { const int c = 128 * j + 2 * lane; *(unsigned*)(WSP(bf16, WS_CQN) + (size_t)row * 512 + c) = pk2(x[2 * j] * rinv * cqg[c], x[2 * j + 1] * rinv * cqg[c + 1]); } }
                { float x[4]; float ss = 0.f;
#pragma unroll
                  for (int j = 0; j < 2; ++j) { x[2 * j] = bflo(CKw[j]); x[2 * j + 1] = bfhi(CKw[j]); ss += x[2 * j] * x[2 * j] + x[2 * j + 1] * x[2 * j + 1]; }
                  const float rinv = rsqrtf(wave_sum(ss, lane) * (1.f / 256.f) + 1e-6f);
#pragma unroll
                  for (int j = 0; j < 2; ++j) { const int c = 128 * j + 2 * lane; *(unsigned*)(WSP(bf16, WS_CKVN) + (size_t)row * 256 + c) = pk2(x[2 * j] * rinv * ckg[c], x[2 * j + 1] * rinv * ckg[c + 1]); } }
                { const int d = lane & 31; float x = xkr; const float xo = shx(x, 8, lane);
                  if (row < ML) { const int hd = d >> 4, w = d & 15, i = w & 7; const float pos = (float)(hd ? (t & 63) : (t >> 6)); const float ang = pos * rope_inv(i); const float sn = __sinf(ang), cs = __cosf(ang);
                      x = (w < 8) ? (x * cs - xo * sn) : (xo * sn + x * cs); }
                  bf16* km = WSP(bf16, WS_KV) + (size_t)row * 1536 + 64 + d; const bf16 xb = (bf16)f2bf(x);
#pragma unroll
                  for (int h2 = 0; h2 < 8; ++h2) km[(2 * h2 + (lane >> 5)) * 96] = xb; }
            }
        }
        SEAM(pb + 2);

        if (PHEN(4) && IN(pb + 3)) REPL(4) {
            FRAME();
            const float* MODL = WSP(float, WS_MODF) + (size_t)l * 9 * 12288; (void)MODL;
            { pg8::SchedSmall S; S.a0 = (unsigned)WS_LA; S.b0 = (unsigned)WS_WA; S.a1 = (unsigned)WS_LG; S.b1 = (unsigned)WS_WG; S.a2 = (unsigned)WS_CKVN; S.b2 = (unsigned)WS_WUKV;
              S.a3 = (unsigned)(WS_WUKV + (size_t)1024 * 256 * 2); S.b3 = (unsigned)WS_CKVN; S.G = F.G; S.c = F.bid;
              pg8::EpiSmall E{WSP(_Float16, WS_DEC), WSP(bf16, WS_AA), INP(11) + l * 2048, INP(13) + l * 2048, WSP(bf16, WS_G), WSP(bf16, WS_KV), WSP(bf16, WS_VTM)};
              pg8::gemm_phase(F.lds, F.ws, 256, S, E); }
            { pg8::SchedDense S; S.init(WS_CQN, WS_WUQ, M, 1536, 512, F.G, F.bid);
              pg8::EpiStoreBf16 E{WSP(bf16, WS_Q), 1536, 0};
              pg8::gemm_phase(F.lds, F.ws, 512, S, E); }
        }
        SEAM(pb + 3);

        if (PHEN(5) && IN(pb + 4)) REPL(5) {
            FRAME();
            const float* MODL = WSP(float, WS_MODF) + (size_t)l * 9 * 12288; (void)MODL;
            const bf16* U = WSP(bf16, WS_BIG);
            if (MIXM & 1) for (int ch = F.bid; ch < 256; ch += F.G) {
                scan_chain(F.lds, F.tid, l, ch, WSP(bf16, WS_RS), WSP(bf16, WS_KS), WSP(bf16, WS_VS), WSP(bf16, WS_KK), WSP(_Float16, WS_DEC), WSP(bf16, WS_AA), INP(17) + l * 1024, WSP(bf16, WS_YS));
                __syncthreads();
            }
            __syncthreads();
            {
                const bf16* U = WSP(bf16, WS_BIG);
                const float LOG2E = 1.4426950408889634f;
                const int xcd = F.bid & 7, slot = F.bid >> 3; const bool deal = (F.G == 256);
                if (MIXM & 4) for (int i = 0; ; ++i) {
                    int un; if (deal) { if (i >= 4) break; un = (i * 32 + xcd * 4 + (slot >> 3)) * 8 + (slot & 7); } else { un = F.bid + i * F.G; if (un >= 1024) break; }
                    const int qb = un & 7, h = (un >> 3) & 15, b = un >> 7; const int q0 = b * T + qb * 256;
                    attn_unit<96, 1>(F.lds, F.tid, WSP(bf16, WS_Q) + (size_t)q0 * 1536 + h * 96, 1536, 0.10206207261596577f * LOG2E, qb * 256,
                                     WSP(bf16, WS_KV) + h * 96, 1536, WSP(bf16, WS_VTM) + (size_t)(h * 64) * M, M, 32, b * T, 4, ML + b * TC,
                                     WSP(bf16, WS_YNA) + (size_t)q0 * 3072 + 2048 + h * 64, nullptr, 0, 0);
                }
                if (MIXM & 2) for (int i = 0; ; ++i) {
                    int un; if (deal) { if (i >= 4) break; un = (i * 32 + xcd * 4 + (slot >> 3)) * 8 + (slot & 7); } else { un = F.bid + i * F.G; if (un >= 1024) break; }
                    const int ig = un & 7, h = (un >> 3) & 15, b = un >> 7; const int i0 = 4 * ig, q0 = b * T + i0 * 64;
                    int rlo = i0 - 4; rlo = rlo < 0 ? 0 : (rlo > 24 ? 24 : rlo); int rhi = i0 + 3 - 4; rhi = (rhi < 0 ? 0 : (rhi > 24 ? 24 : rhi)) + 8;
                    attn_unit<64, 2>(F.lds, F.tid, U + (size_t)q0 * UW + O_NAQ + h * 64, UW, 0.125f * LOG2E, 0,
                                     U + O_NAK + h * 64, UW, WSP(bf16, WS_VTN) + (size_t)(h * 64) * M, M, rhi - rlo, b * T + rlo * 64, 4, ML + b * TC,
                                     WSP(bf16, WS_YNA) + (size_t)q0 * 3072 + h * 64, INP(9) + (size_t)(l * 16 + h) * 465, i0, rlo);
                }
                if ((MIXM & 8) && l == 0) {
                    for (int un = F.bid; un < 128; un += F.G) { const int h = un & 15, b = un >> 4; const int q0 = ML + b * TC;
                        attn_unit<64, 0>(F.lds, F.tid, U + (size_t)q0 * UW + O_NAQ + h * 64, UW, 0.125f * LOG2E, 0,
                                         U + O_NAK + h * 64, UW, WSP(bf16, WS_VTN) + (size_t)(h * 64) * M, M, 0, 0, 4, q0,
                                         WSP(bf16, WS_YNA) + (size_t)q0 * 3072 + h * 64, nullptr, 0, 0); }
                    for (int un = (F.bid + F.G - 128 % F.G) % F.G; un < 128; un += F.G) { const int h = un & 15, b = un >> 4; const int q0 = ML + b * TC;
                        attn_unit<96, 0>(F.lds, F.tid, WSP(bf16, WS_Q) + (size_t)q0 * 1536 + h * 96, 1536, 0.10206207261596577f * LOG2E, 0,
                                         WSP(bf16, WS_KV) + h * 96, 1536, WSP(bf16, WS_VTM) + (size_t)(h * 64) * M, M, 0, 0, 4, q0,
                                         WSP(bf16, WS_YNA) + (size_t)q0 * 3072 + 2048 + h * 64, nullptr, 0, 0); }
                }
            }
        }
        SEAM(pb + 4);

        if (PHEN(6) && IN(pb + 5)) REPL(6) {
            FRAME();
            LAS float* crk = (LAS float*)F.lds; LAS float* cgw = crk + 1024; LAS float* cgb = cgw + 1024;
            { const float* rk_ = INP(18) + l * 1024; const float* gnw_ = INP(19) + l * 1024; const float* gnb_ = INP(20) + l * 1024;
              for (int i = F.tid; i < 1024; i += NTHR) { crk[i] = rk_[i]; cgw[i] = gnw_[i]; cgb[i] = gnb_[i]; } }
            __syncthreads();
            for (int row = gw; row < Mrows; row += NGW) {
                unsigned ya[8], yb[8], rw[8], kw[8], vw[8], gq[8];
#pragma unroll
                for (int j = 0; j < 8; ++j) { const size_t o = (size_t)row * 1024 + 128 * j + 2 * lane;
                    ya[j] = *(const unsigned*)(WSP(bf16, WS_YS) + o); yb[j] = *(const unsigned*)(WSP(bf16, WS_YS) + (size_t)M * 1024 + o);
                    rw[j] = *(const unsigned*)(WSP(bf16, WS_RS) + o); kw[j] = *(const unsigned*)(WSP(bf16, WS_KS) + o); vw[j] = *(const unsigned*)(WSP(bf16, WS_VS) + o); gq[j] = *(const unsigned*)(WSP(bf16, WS_G) + o); }
#pragma unroll
                for (int j = 0; j < 8; ++j) { const int c = 128 * j + 2 * lane;
                    const float y0 = bflo(ya[j]) + bflo(yb[j]), y1 = bfhi(ya[j]) + bfhi(yb[j]);
                    const float mean = half_sum(y0 + y1, lane) * (1.f / 64.f); const float d0 = y0 - mean, d1 = y1 - mean;
                    const float var = half_sum(d0 * d0 + d1 * d1, lane) * (1.f / 64.f); const float rs = rsqrtf(var + 64e-5f);
                    const float bd = half_sum(bflo(rw[j]) * bflo(kw[j]) * crk[c] + bfhi(rw[j]) * bfhi(kw[j]) * crk[c + 1], lane);
                    const float o0 = (d0 * rs * cgw[c] + cgb[c] + bd * bflo(vw[j])) * bflo(gq[j]), o1 = (d1 * rs * cgw[c + 1] + cgb[c + 1] + bd * bfhi(vw[j])) * bfhi(gq[j]);
                    *(unsigned*)(WSP(bf16, WS_YNA) + (size_t)row * 3072 + 1024 + c) = pk2(o0, o1); }
            }
        }
        SEAM(pb + 5);

        if (PHEN(7) && IN(pb + 6)) REPL(7) {
            FRAME();
            pg8::SchedDense S; S.init(WS_YNA, WS_WB, Mrows, D, 3072, F.G, F.bid);
            pg8::EpiBranch E{WSP(bf16, WS_MB), WSP(bf16, WS_BIG)};
            pg8::gemm_phase(F.lds, F.ws, 3072, S, E);
            if (l == 0 && F.G == 256 && F.bid >= 64) convert_weights(F, 1, 1 | 32, (F.bid - 64) * NWAVES + F.wave, 192 * NWAVES, (F.bid - 64) * NTHR + F.tid, 192 * NTHR);
        }
        SEAM(pb + 6);

        if (PHEN(8) && IN(pb + 7)) REPL(8) {
            FRAME();
            const float* MODL = WSP(float, WS_MODF) + (size_t)l * 9 * 12288; (void)MODL;
            pg8::SchedDense S; S.init(WS_MB, WS_WO, Mrows, D, D, F.G, F.bid);
            const float* bl_ = (l == 0) ? INP(0) : (const float*)WSP(float, WS_XR); const float* bc_ = (l == 0) ? INP(2) : (const float*)(WSP(float, WS_XR) + (size_t)ML * D);
            pg8::EpiResidual E{WSP(float, WS_XR), MODL + 4096, bl_, bc_};
            pg8::gemm_phase(F.lds, F.ws, D, S, E);
            if (l == 0 && F.G == 256 && F.bid >= 64) convert_weights(F, 1, 2 | 16, (F.bid - 64) * NWAVES + F.wave, 192 * NWAVES, (F.bid - 64) * NTHR + F.tid, 192 * NTHR);
        }
        SEAM(pb + 7);

        if (PHEN(9) && IN(pb + 8)) REPL(9) {
            FRAME();
            const float* MODL = WSP(float, WS_MODF) + (size_t)l * 9 * 12288; (void)MODL;
            const float* gp = INP(7) + l * D; const float* rbias = INP(28);
            int* TOKE = WSP(int, WS_ROUTE); int* TOKP = TOKE + 2 * M; float* TOKW = (float*)(TOKP + 2 * M);
            LAS float* lsc = (LAS float*)(F.lds + F.wave * 2048);
            const int rr = lane & 15, kg = lane >> 4;
            const bool split = (NGW == 2048) && (Mrows == M);
            for (int it = 0; ; ++it) {
                int rowbase, R;
                if (!split) { const int tile = gw + it * NGW; if (tile >= Mrows / 8) break; rowbase = tile * 8; R = 8; }
                else if (it == 0) { rowbase = gw * 8; R = 8; }
                else if (it == 1 && F.wave < 2) { const int hh_ = F.bid * 2 + F.wave; rowbase = (2048 + (hh_ >> 1)) * 8 + (hh_ & 1) * 4; R = 4; }
                else break;
                const int r8 = lane & (R - 1);
                const int b = rowbase < ML ? rowbase / T : 8;
                const f32x4* sc = (const f32x4*)(MODL + (size_t)b * 12288 + 8192); const f32x4* sh = (const f32x4*)(MODL + (size_t)b * 12288 + 6144);
                f32x4 ga[8], gs[8];
#pragma unroll
                for (int j = 0; j < 8; ++j) { const int c4 = lane + 64 * j; ga[j] = ((const f32x4*)gp)[c4] * (sc[c4] + 1.0f); gs[j] = sh[c4]; }
#pragma unroll 2
                for (int r = 0; r < R; ++r) { const f32x4* xr = WSP(f32x4, WS_XR) + (size_t)(rowbase + r) * (D / 4); f32x4 v[8]; float ss = 0.f;
#pragma unroll
                    for (int j = 0; j < 8; ++j) { v[j] = xr[lane + 64 * j]; ss += (v[j].x * v[j].x + v[j].y * v[j].y) + (v[j].z * v[j].z + v[j].w * v[j].w); }
                    const float ri = rsqrtf(wave_sum(ss, lane) * (1.f / D) + 1e-6f);
                    if (lane == 0) lsc[256 + r] = ri;
#pragma unroll
                    for (int j = 0; j < 8; ++j) { const int c4 = lane + 64 * j; const f32x4 hh = (v[j] * ri) * ga[j] + gs[j];
                        u32x2 w; w.x = pk2(hh.x, hh.y); w.y = pk2(hh.z, hh.w); ((u32x2*)(WSP(bf16, WS_H) + (size_t)(rowbase + r) * D))[c4] = w; } }
                const float* xrow = WSP(float, WS_XR) + (size_t)(rowbase + r8) * D + 8 * kg;
                const bf16* wh = WSP(bf16, WS_WRB) + ((size_t)(l * 9 + b) * 2 * 16 + rr) * D + 8 * kg; const bf16* wl = wh + 16 * D;
                f32x4 acc = (f32x4){0.f, 0.f, 0.f, 0.f};
#pragma unroll 8
                for (int st = 0; st < 64; ++st) { const int k0 = 32 * st;
                    const f32x4 x0 = *(const f32x4*)(xrow + k0), x1 = *(const f32x4*)(xrow + k0 + 4);
                    u32x4 hi; hi.x = pk2(x0.x, x0.y); hi.y = pk2(x0.z, x0.w); hi.z = pk2(x1.x, x1.y); hi.w = pk2(x1.z, x1.w);
                    u32x4 lo; lo.x = pk2(x0.x - bflo(hi.x), x0.y - bfhi(hi.x)); lo.y = pk2(x0.z - bflo(hi.y), x0.w - bfhi(hi.y)); lo.z = pk2(x1.x - bflo(hi.z), x1.y - bfhi(hi.z)); lo.w = pk2(x1.z - bflo(hi.w), x1.w - bfhi(hi.w));
                    const bf16x8 bh = *(const bf16x8*)(wh + k0), bl = *(const bf16x8*)(wl + k0);
                    acc = __builtin_amdgcn_mfma_f32_16x16x32_bf16(__builtin_bit_cast(bf16x8, hi), bh, acc, 0, 0, 0);
                    acc = __builtin_amdgcn_mfma_f32_16x16x32_bf16(__builtin_bit_cast(bf16x8, lo), bh, acc, 0, 0, 0);
                    acc = __builtin_amdgcn_mfma_f32_16x16x32_bf16(__builtin_bit_cast(bf16x8, hi), bl, acc, 0, 0, 0); }
                LDS_WAIT();
                { const float cb = WSP(float, WS_CB)[(l * 9 + b) * 16 + rr];
                  if (kg < 2) {
#pragma unroll
                      for (int i = 0; i < 4; ++i) lsc[(4 * kg + i) * 16 + rr] = acc[i] * lsc[256 + 4 * kg + i] + cb; } }
                LDS_WAIT();
                if (lane < R) { const int row = rowbase + lane;
                    float scs[16], sel[16];
#pragma unroll
                    for (int e4 = 0; e4 < 4; ++e4) { const f32x4 q4 = *(const LAS f32x4*)(lsc + lane * 16 + 4 * e4);
#pragma unroll
                        for (int i = 0; i < 4; ++i) { scs[4 * e4 + i] = sigm(q4[i]); sel[4 * e4 + i] = scs[4 * e4 + i] + rbias[4 * e4 + i]; } }
                    int bg = 0; float bgs = -1e30f;
#pragma unroll
                    for (int g4 = 0; g4 < 4; ++g4) { float m1 = -1e30f, m2 = -1e30f;
#pragma unroll
                        for (int i = 0; i < 4; ++i) { const float s_ = sel[4 * g4 + i]; if (s_ > m1) { m2 = m1; m1 = s_; } else if (s_ > m2) m2 = s_; }
                        const float gs = m1 + m2; if (gs > bgs) { bgs = gs; bg = g4; } }
                    int e1 = 0, e2 = 0; float s1 = -1e30f, s2 = -1e30f, c1 = 0.f, c2 = 0.f;
#pragma unroll
                    for (int g4 = 0; g4 < 4; ++g4)
#pragma unroll
                        for (int i = 0; i < 4; ++i) { const int e = 4 * g4 + i; const float s_ = sel[e], cc = scs[e];
                            if (g4 == bg) { if (s_ > s1) { s2 = s1; e2 = e1; c2 = c1; s1 = s_; e1 = e; c1 = cc; } else if (s_ > s2) { s2 = s_; e2 = e; c2 = cc; } } }
                    const unsigned p1 = atomicAdd(F.ctl + CW_CNT + l * 64 + e1, 1u), p2 = atomicAdd(F.ctl + CW_CNT + l * 64 + e2, 1u);
                    TOKE[2 * row] = e1; TOKE[2 * row + 1] = e2; TOKP[2 * row] = (int)p1; TOKP[2 * row + 1] = (int)p2;
                    { int* LIST = (int*)(F.ws + WS_ROUTE + 0xC0000); LIST[(size_t)e1 * M + p1] = row; LIST[(size_t)e2 * M + p2] = row; }
                    const float inv = __builtin_amdgcn_rcpf(c1 + c2); TOKW[2 * row] = c1 * inv; TOKW[2 * row + 1] = c2 * inv; }
                LDS_WAIT();
            }
        }
        SEAM(pb + 8);

        if (PHEN(10) && IN(pb + 9)) REPL(10) {
            FRAME();
            const float* MODL = WSP(float, WS_MODF) + (size_t)l * 9 * 12288; (void)MODL;
            int* TOKE = WSP(int, WS_ROUTE); int* TOKP = TOKE + 2 * M; int* DEST = TOKP + 4 * M; int* TILE_E = DEST + 2 * M;
            unsigned cnt = 0u; if (lane < 16) cnt = __hip_atomic_load(F.ctl + CW_CNT + l * 64 + lane, RLX_AGENT);
            const unsigned pad = (cnt + 255u) & ~255u;
            unsigned incl = pad;
#pragma unroll
            for (int o = 1; o < 16; o <<= 1) { const unsigned t = shl_u(incl, lane - o); if (lane >= o) incl += t; }
            const unsigned excl = incl - pad;
            if (F.bid == 0 && F.wave == 0) {
                const unsigned total = shl_u(incl, 15);
                for (int tl = lane; tl < MAXT; tl += 64) { int e = 0, p0 = 0, cn = 0;
#pragma unroll
                    for (int q = 0; q < 16; ++q) { const unsigned st = shl_u(excl, q), en = shl_u(incl, q), cq = shl_u(cnt, q); if ((unsigned)tl * 256u >= st && (unsigned)tl * 256u < en) { e = q; p0 = (int)((unsigned)tl * 256u - st); cn = (int)cq; } }
                    TILE_E[tl] = e; TILE_E[256 + tl] = p0; TILE_E[512 + tl] = cn; }
                if (lane == 0) TILE_E[MAXT] = (int)(total >> 8);
            }
            for (int r0 = gw * 32; r0 < Mrows; r0 += NGW * 32) {
                const int idx = 2 * r0 + lane; const int e = TOKE[idx], p = TOKP[idx];
                DEST[idx] = (int)shl_u(excl, e) + p; }
        }
        SEAM(pb + 9);

        if (PHEN(11) && IN(pb + 10)) REPL(11) {
            FRAME();
            const float* MODL = WSP(float, WS_MODF) + (size_t)l * 9 * 12288; (void)MODL;
            const int* TILE_E = WSP(int, WS_ROUTE) + 8 * M;
            pg8::SchedMoeG S; S.A = (unsigned)WS_H; S.B = (unsigned)WS_GU; S.K2 = (unsigned)D * 2; S.btstep = 256u * D * 2; S.estep = 2048u * D * 2;
            S.tile_e = TILE_E; S.tile_p0 = TILE_E + 256; S.tile_cn = TILE_E + 512; S.list = (const int*)(F.ws + WS_ROUTE + 0xC0000); S.ntiles = TILE_E[MAXT]; S.nN = 8; S.G = F.G; S.c = F.bid;
            pg8::EpiSwiglu E{WSP(bf16, WS_ACT)};
            pg8::gemm_phase(F.lds, F.ws, D, S, E);
        }
        SEAM(pb + 10);

        if (PHEN(12) && IN(pb + 11)) REPL(12) {
            FRAME();
            const float* MODL = WSP(float, WS_MODF) + (size_t)l * 9 * 12288; (void)MODL;
            const int* TILE_E = WSP(int, WS_ROUTE) + 8 * M;
            pg8::SchedMoe S; S.A = (unsigned)WS_ACT; S.B = (unsigned)(l == 0 ? WS_DN : WS_DN1); S.atstep = 256u * FE * 2; S.btstep = 256u * FE * 2; S.estep = (unsigned)D * FE * 2;
            S.tile_e = TILE_E; S.ntiles = TILE_E[MAXT]; S.nN = 8; S.G = F.G; S.c = F.bid;
            pg8::EpiStoreBf16 E{WSP(bf16, WS_OUTB), D, 0};
            pg8::gemm_phase(F.lds, F.ws, FE, S, E);
        }
        SEAM(pb + 11);

        if (PHEN(13) && IN(pb + 12)) REPL(13) {
            FRAME();
            const float* MODL = WSP(float, WS_MODF) + (size_t)l * 9 * 12288; (void)MODL;
            const int* DEST = WSP(int, WS_ROUTE) + 6 * M; const float* TOKW = (const float*)(WSP(int, WS_ROUTE) + 4 * M);
            const float* n1g1_ = INP(6) + D; const f32x4* fng_ = (const f32x4*)INP(31);
            const float* MOD1 = WSP(float, WS_MODF) + (size_t)9 * 12288;
            int nd0 = 0, nd1 = 0; float nw0 = 0.f, nw1 = 0.f;
            if (gw < Mrows) { nd0 = DEST[2 * gw]; nd1 = DEST[2 * gw + 1]; nw0 = TOKW[2 * gw]; nw1 = TOKW[2 * gw + 1]; }
#pragma unroll 1
            for (int row = gw; row < Mrows; row += NGW) {
                const int b = row < ML ? row / T : 8;
                const int d0 = nd0, d1 = nd1; const float w0 = nw0, w1 = nw1;
                f32x4* xr = WSP(f32x4, WS_XR) + (size_t)row * (D / 4);
                const u32x2* o0 = (const u32x2*)(WSP(bf16, WS_OUTB) + (size_t)d0 * D); const u32x2* o1 = (const u32x2*)(WSP(bf16, WS_OUTB) + (size_t)d1 * D);
                const f32x4* g2 = (const f32x4*)(MODL + (size_t)b * 12288 + 10240);
                f32x4 v[8]; float ss = 0.f;
                { u32x2 oa[8], oc[8]; f32x4 xv[8], gv2[8];
#pragma unroll
                  for (int j = 0; j < 8; ++j) { const int c4 = lane + 64 * j; oa[j] = o0[c4]; oc[j] = o1[c4]; xv[j] = xr[c4]; gv2[j] = g2[c4]; }
                  { const int nr = row + NGW; if (nr < Mrows) { nd0 = DEST[2 * nr]; nd1 = DEST[2 * nr + 1]; nw0 = TOKW[2 * nr]; nw1 = TOKW[2 * nr + 1]; } }
#pragma unroll
                  for (int j = 0; j < 8; ++j) { const u32x2 a_ = oa[j], c_ = oc[j];
                      f32x4 f; f.x = w0 * bflo(a_.x) + w1 * bflo(c_.x); f.y = w0 * bfhi(a_.x) + w1 * bfhi(c_.x); f.z = w0 * bflo(a_.y) + w1 * bflo(c_.y); f.w = w0 * bfhi(a_.y) + w1 * bfhi(c_.y);
                      v[j] = xv[j] + gv2[j] * f; ss += (v[j].x * v[j].x + v[j].y * v[j].y) + (v[j].z * v[j].z + v[j].w * v[j].w); } }
                asm volatile("" ::: "memory");
                const float rinv = rsqrtf(wave_sum(ss, lane) * (1.f / D) + 1e-6f);
                if (l == 0) {
                    f32x4 ng[8], nsc[8], nsh[8];
#pragma unroll
                    for (int j = 0; j < 8; ++j) { const int c4 = lane + 64 * j; ng[j] = ((const f32x4*)n1g1_)[c4]; nsc[j] = ((const f32x4*)(MOD1 + (size_t)b * 12288 + 2048))[c4]; nsh[j] = ((const f32x4*)(MOD1 + (size_t)b * 12288))[c4]; }
#pragma unroll
                    for (int j = 0; j < 8; ++j) { const int c4 = lane + 64 * j; xr[c4] = v[j];
                        const f32x4 hh = (v[j] * rinv) * ng[j] * (nsc[j] + 1.0f) + nsh[j];
                        u32x2 w; w.x = pk2(hh.x, hh.y); w.y = pk2(hh.z, hh.w); ((u32x2*)(WSP(bf16, WS_H) + (size_t)row * D))[c4] = w; }
                } else {
                    f32x4 ng[8];
#pragma unroll
                    for (int j = 0; j < 8; ++j) ng[j] = fng_[lane + 64 * j];
#pragma unroll
                    for (int j = 0; j < 8; ++j) { const int c4 = lane + 64 * j; ((f32x4*)(F.out + (size_t)row * D))[c4] = (v[j] * rinv) * ng[j]; }
                }
            }
            if (l == 0) { __syncthreads(); convert_weights(F, 1, F.G == 256 ? (4 | 8) : 63, F.bid * NWAVES + F.wave, F.G * NWAVES, F.bid * NTHR + F.tid, F.G * NTHR); }
        }
        if (l == 0) SEAM(pb + 12);
    }
#undef IN
#undef SEAM
}

typedef void (*kern_t)(Args);
template <unsigned PM> static bool prep_kernel() {
    if (hipFuncSetAttribute((const void*)fwd_kernel<PM>, hipFuncAttributeMaxDynamicSharedMemorySize, LDS_BYTES) != hipSuccess) { fprintf(stderr, "kernel_launch: hipFuncSetAttribute failed\n"); return false; }
    return true;
}
extern "C" void kernel_launch(void* const* d_in, const int* in_sizes, int n_in, void* d_out, int out_size, void* d_ws, size_t ws_size, hipStream_t stream) {
    static int grid = 0;
#if MK_N_LAUNCHES == 1
    static kern_t kern[1] = { fwd_kernel<0x3FFFu> };
#else
    static kern_t kern[14] = { fwd_kernel<1u << 0>, fwd_kernel<1u << 1>, fwd_kernel<1u << 2>, fwd_kernel<1u << 3>, fwd_kernel<1u << 4>, fwd_kernel<1u << 5>, fwd_kernel<1u << 6>, fwd_kernel<1u << 7>,
                               fwd_kernel<1u << 8>, fwd_kernel<1u << 9>, fwd_kernel<1u << 10>, fwd_kernel<1u << 11>, fwd_kernel<1u << 12>, fwd_kernel<1u << 13> };
#endif
    if (grid == 0) {
        if (n_in != 32 || out_size != ML * D || ws_size < WS_END) { fprintf(stderr, "kernel_launch: unexpected problem: n_in %d out %d ws %zu\n", n_in, out_size, ws_size); grid = -1; return; }
        int dev = 0, cus = 0;
        if (hipGetDevice(&dev) != hipSuccess || hipDeviceGetAttribute(&cus, hipDeviceAttributeMultiprocessorCount, dev) != hipSuccess) { grid = -1; return; }
        bool ok = true;
#if MK_N_LAUNCHES == 1
        ok = prep_kernel<0x3FFFu>();
        int per_cu = 0;
        if (hipOccupancyMaxActiveBlocksPerMultiprocessor(&per_cu, (const void*)fwd_kernel<0x3FFFu>, NTHR, LDS_BYTES) != hipSuccess || per_cu < 1) { fprintf(stderr, "kernel_launch: occupancy query says %d\n", per_cu); }
#else
        ok = prep_kernel<1u << 0>() && prep_kernel<1u << 1>() && prep_kernel<1u << 2>() && prep_kernel<1u << 3>() && prep_kernel<1u << 4>() && prep_kernel<1u << 5>() && prep_kernel<1u << 6>() && prep_kernel<1u << 7>()
          && prep_kernel<1u << 8>() && prep_kernel<1u << 9>() && prep_kernel<1u << 10>() && prep_kernel<1u << 11>() && prep_kernel<1u << 12>() && prep_kernel<1u << 13>();
#endif
        (void)hipGetLastError();
        if (!ok) { grid = -1; return; }
        grid = cus;
    }
    if (grid < 0) return;
    if (hipMemsetAsync((char*)d_ws + WS_CTL, 0, CTL_ZERO_BYTES, stream) != hipSuccess) return;
    Args a{};
    for (int i = 0; i < 32; ++i) a.in[i] = (const float*)d_in[i];
    a.out = (float*)d_out; a.ws = (unsigned char*)d_ws;
#if MK_N_LAUNCHES == 1
    a.ph_lo = 0; a.ph_hi = N_PHASES;
    hipLaunchKernelGGL(kern[0], dim3(grid), dim3(NTHR), LDS_BYTES, stream, a);
#else
    for (int p = 0; p < N_PHASES; ++p) {
        if (p == 1 + PH_PER_LAYER) continue;
        a.ph_lo = p; a.ph_hi = p + 1;
        const int j = p == 0 ? 0 : 1 + (p - 1) % PH_PER_LAYER;
        hipLaunchKernelGGL(kern[j], dim3(grid), dim3(NTHR), LDS_BYTES, stream, a);
    }
#endif
}
```
